# Optimizing an MI355X kernel written in HIP

```python
import math
import jax
import jax.numpy as jnp
from jax import lax
import numpy as np

D_MODEL = 1024
BATCH = 8
SEQ = 2048
DEPTH = 1
DEC_BATCH = 128
DEC_SEQ = 1
PAST_LEN = 2048
PAGE_SIZE = 128

D_MIX = 2 * D_MODEL
D_M = D_MIX // 2
H_M = 4
DH_M = D_M // H_M
D_D = D_MIX // 4
H_D = 4
DV_D = D_D // H_D
DQK_D = DV_D // 2
D_C = D_MIX // 4
H_C = 4
DH_C = D_C // H_C
N_MEM = 256
D_IN = 4 * D_M + 2 * H_M + 3 * D_D + D_C + D_MIX
CHUNK = 128
Q_BLOCK = 128
ROPE_THETA = 10000.0
EPS = 1e-5
ALPHA = (2 * DEPTH) ** 0.25
BETA = (8 * DEPTH) ** -0.25
POOL_NUM = 5
POOL_DEN = 4

kernel_name = "hybrid_mlstm_diffattn_memxattn_step"


def split_in(z):
    sizes = (D_M, D_M, D_M, D_M, H_M, H_M, D_D, D_D, D_D, D_C, D_MIX)
    points = []
    acc = 0
    for s in sizes[:-1]:
        acc += s
        points.append(acc)
    return jnp.split(z, points, axis=-1)


def rope(t, pos):
    half = t.shape[-1] // 2
    inv_freq = ROPE_THETA ** (-jnp.arange(half, dtype=jnp.float32) / half)
    ang = pos.astype(jnp.float32)[:, None] * inv_freq[None, :]
    cos = jnp.cos(ang)[:, None, :]
    sin = jnp.sin(ang)[:, None, :]
    t32 = t.astype(jnp.float32)
    t1, t2 = t32[..., :half], t32[..., half:]
    return jnp.concatenate([t1 * cos - t2 * sin, t2 * cos + t1 * sin], axis=-1).astype(t.dtype)


def layer_norm(y, g, b):
    y32 = y.astype(jnp.float32)
    mu = jnp.mean(y32, axis=-1, keepdims=True)
    var = jnp.mean(jnp.square(y32 - mu), axis=-1, keepdims=True)
    out = (y32 - mu) * lax.rsqrt(var + EPS) * g.astype(jnp.float32) + b.astype(jnp.float32)
    return out.astype(y.dtype)


def branch_inputs(x, pos, w_in_l, b_if_l):
    b, l, _ = x.shape
    mq, mk, mv, mo, mi, mf, dq, dk, dv, cq, gate = split_in(x @ w_in_l)

    def to_bhld(t):
        return jnp.swapaxes(t.reshape(b, l, H_M, DH_M), 1, 2).astype(jnp.float32)

    q_m = to_bhld(mq)
    k_m = to_bhld(mk) * (DH_M ** -0.5)
    v_m = to_bhld(mv)
    ig = jnp.swapaxes((mi + b_if_l[:H_M]).astype(jnp.float32), 1, 2)
    lf = jax.nn.log_sigmoid(jnp.swapaxes((mf + b_if_l[H_M:]).astype(jnp.float32), 1, 2))
    dq = rope(dq.reshape(b, l, 2 * H_D, DQK_D), pos).reshape(b, l, H_D, 2, DQK_D)
    dk = rope(dk.reshape(b, l, 2 * H_D, DQK_D), pos).reshape(b, l, H_D, 2, DQK_D)
    dv = dv.reshape(b, l, H_D, DV_D)
    cq = cq.reshape(b, l, H_C, DH_C)
    return q_m, k_m, v_m, ig, lf, mo, dq, dk, dv, cq, gate


def mlstm_chunkwise(q, k, v, ig, lf, c0, n0, m0):
    b, h, l, _ = q.shape
    dv = v.shape[-1]
    c = CHUNK if l % CHUNK == 0 else l
    nc = l // c

    def blocks(t):
        return jnp.moveaxis(t.reshape((b, h, nc, c) + t.shape[3:]), 2, 0)

    tri = jnp.tril(jnp.ones((c, c), dtype=bool))

    def step(carry, xs):
        cm, nv, m = carry
        qc, kc, vc, ic, fc = xs
        bcum = jnp.cumsum(fc, axis=-1)
        dlog = jnp.where(tri, bcum[..., :, None] - bcum[..., None, :] + ic[..., None, :], -jnp.inf)
        inter = bcum + m[..., None]
        mt = jnp.maximum(jnp.max(dlog, axis=-1), inter)
        w_intra = jnp.exp(dlog - mt[..., None])
        w_inter = jnp.exp(inter - mt)
        s = jnp.einsum('bhtd,bhsd->bhts', qc, kc) * w_intra
        num = jnp.einsum('bhts,bhsv->bhtv', s, vc) + w_inter[..., None] * jnp.einsum('bhtd,bhdv->bhtv', qc, cm)
        den = jnp.sum(s, axis=-1) + w_inter * jnp.einsum('bhtd,bhd->bht', qc, nv)
        hc = num / jnp.maximum(jnp.abs(den), jnp.exp(-mt))[..., None]
        m_new = mt[..., -1]
        w_end = jnp.exp(bcum[..., -1:] - bcum + ic - m_new[..., None])
        decay = jnp.exp(bcum[..., -1] + m - m_new)
        c_new = decay[..., None, None] * cm + jnp.einsum('bhs,bhsd,bhsv->bhdv', w_end, kc, vc)
        n_new = decay[..., None] * nv + jnp.einsum('bhs,bhsd->bhd', w_end, kc)
        return (c_new, n_new, m_new), hc

    (c_f, n_f, m_f), hs = lax.scan(step, (c0, n0, m0), (blocks(q), blocks(k), blocks(v), blocks(ig), blocks(lf)))
    hs = jnp.moveaxis(hs, 0, 2).reshape(b, h, l, dv)
    return hs, c_f, n_f, m_f


def mlstm_readout(hm, o_pre, g):
    b, _, l, _ = hm.shape
    mu = jnp.mean(hm, axis=-1, keepdims=True)
    var = jnp.mean(jnp.square(hm - mu), axis=-1, keepdims=True)
    hn = (hm - mu) * lax.rsqrt(var + EPS) * g.astype(jnp.float32).reshape(H_M, 1, DH_M)
    hn = jnp.swapaxes(hn, 1, 2).reshape(b, l, D_M)
    return hn * jax.nn.sigmoid(o_pre.astype(jnp.float32))


def diff_attend(q, k, v, lam, q_pos, k_pos):
    s = jnp.einsum('bqhcd,bkhcd->bhcqk', q, k).astype(jnp.float32) * (DQK_D ** -0.5)
    mask = k_pos[None, :] <= q_pos[:, None]
    p = jax.nn.softmax(jnp.where(mask, s, -jnp.inf), axis=-1)
    a = p[:, :, 0] - lam * p[:, :, 1]
    return jnp.einsum('bhqk,bkhd->bqhd', a.astype(v.dtype), v)


def diff_attention_prompt(q, k, v, lam):
    b, l = q.shape[:2]
    qb = Q_BLOCK if l % Q_BLOCK == 0 else l
    nb = l // qb
    q_blocks = jnp.moveaxis(q.reshape(b, nb, qb, H_D, 2, DQK_D), 1, 0)
    pos_blocks = jnp.arange(l).reshape(nb, qb)
    k_pos = jnp.arange(l)
    ob = lax.map(lambda a: diff_attend(a[0], k, v, lam, a[1], k_pos), (q_blocks, pos_blocks))
    return jnp.moveaxis(ob, 0, 1).reshape(b, l, H_D, DV_D)


def diff_post(o, g, lam_init):
    o32 = o.astype(jnp.float32)
    o32 = o32 * lax.rsqrt(jnp.mean(o32 * o32, axis=-1, keepdims=True) + EPS) * g.astype(jnp.float32)
    return (o32 * (1.0 - lam_init)).reshape(o.shape[0], o.shape[1], D_D)


def memory_kv(mem, w):
    b, n, _ = mem.shape
    mk, mv = jnp.split(mem @ w, 2, axis=-1)
    return mk.reshape(b, n, H_C, DH_C), mv.reshape(b, n, H_C, DH_C)


def memory_attend(q, mk, mv):
    b, l = q.shape[:2]
    s = jnp.einsum('blhd,bnhd->bhln', q, mk).astype(jnp.float32) * (DH_C ** -0.5)
    p = jax.nn.softmax(s, axis=-1)
    return jnp.einsum('bhln,bnhd->blhd', p.astype(mv.dtype), mv).reshape(b, l, D_C)


def merge_output(x, h_m, h_d, h_c, gate, w_out_l, ln_g_l, ln_b_l):
    h = jnp.concatenate([h_m, h_d, h_c], axis=-1).astype(x.dtype) * jax.nn.silu(gate)
    return layer_norm(ALPHA * x + h @ w_out_l, ln_g_l, ln_b_l)


def setup_inputs(seed: int = 0) -> dict:
    key = jax.random.key(seed)
    ks = jax.random.split(key, 24)
    f32 = jnp.float32
    n_pages = PAST_LEN // PAGE_SIZE
    n_pool = (DEC_BATCH * n_pages * POOL_NUM) // POOL_DEN

    def nrm(k, shape, s=1.0):
        return s * jax.random.normal(k, shape, f32)

    x_prompt = nrm(ks[0], (BATCH, SEQ, D_MODEL))
    x_sample = nrm(ks[1], (DEC_BATCH, DEC_SEQ, D_MODEL))
    state_mlstm_c = nrm(ks[2], (DEPTH, DEC_BATCH, H_M, DH_M, DH_M), 0.1)
    state_mlstm_n = nrm(ks[3], (DEPTH, DEC_BATCH, H_M, DH_M), 0.1)
    state_mlstm_m = nrm(ks[4], (DEPTH, DEC_BATCH, H_M), 0.5)
    cache_diff_k = nrm(ks[5], (DEPTH, n_pool, PAGE_SIZE, H_D, 2 * DQK_D))
    cache_diff_v = nrm(ks[6], (DEPTH, n_pool, PAGE_SIZE, H_D, DV_D))
    cache_mem_k = nrm(ks[7], (DEPTH, DEC_BATCH, N_MEM, H_C, DH_C))
    cache_mem_v = nrm(ks[8], (DEPTH, DEC_BATCH, N_MEM, H_C, DH_C))
    page_table = jax.random.permutation(ks[9], n_pool)[: DEC_BATCH * n_pages].reshape(DEC_BATCH, n_pages).astype(jnp.int32)
    mem_prompt = nrm(ks[10], (BATCH, N_MEM, D_MODEL))
    w_in = nrm(ks[11], (DEPTH, D_MODEL, D_IN), D_MODEL ** -0.5)
    b_i = nrm(ks[12], (DEPTH, H_M), 0.1)
    b_f = jnp.linspace(3.0, 6.0, H_M, dtype=f32)[None, :] + nrm(ks[13], (DEPTH, H_M), 0.1)
    b_if = jnp.concatenate([b_i, b_f], axis=-1)
    w_mlstm_norm = 1.0 + nrm(ks[14], (DEPTH, D_M), 0.02)
    lambda_q1 = nrm(ks[15], (DEPTH, DQK_D), 0.1)
    lambda_k1 = nrm(ks[16], (DEPTH, DQK_D), 0.1)
    lambda_q2 = nrm(ks[17], (DEPTH, DQK_D), 0.1)
    lambda_k2 = nrm(ks[18], (DEPTH, DQK_D), 0.1)
    w_diff_norm = 1.0 + nrm(ks[19], (DEPTH, DV_D), 0.02)
    w_mem_kv = nrm(ks[20], (DEPTH, D_MODEL, 2 * D_C), D_MODEL ** -0.5)
    w_out = nrm(ks[21], (DEPTH, D_MIX, D_MODEL), BETA * D_MIX ** -0.5)
    ln_g = 1.0 + nrm(ks[22], (DEPTH, D_MODEL), 0.02)
    ln_b = nrm(ks[23], (DEPTH, D_MODEL), 0.02)
    return {
        "x_prompt": x_prompt, "x_sample": x_sample,
        "state_mlstm_c": state_mlstm_c, "state_mlstm_n": state_mlstm_n, "state_mlstm_m": state_mlstm_m,
        "cache_diff_k": cache_diff_k, "cache_diff_v": cache_diff_v,
        "cache_mem_k": cache_mem_k, "cache_mem_v": cache_mem_v,
        "page_table": page_table, "mem_prompt": mem_prompt,
        "w_in": w_in, "b_if": b_if, "w_mlstm_norm": w_mlstm_norm,
        "lambda_q1": lambda_q1, "lambda_k1": lambda_k1, "lambda_q2": lambda_q2, "lambda_k2": lambda_k2,
        "w_diff_norm": w_diff_norm, "w_mem_kv": w_mem_kv, "w_out": w_out,
        "ln_g": ln_g, "ln_b": ln_b,
    }


def reference(x_prompt, x_sample, state_mlstm_c, state_mlstm_n, state_mlstm_m, cache_diff_k, cache_diff_v,
              cache_mem_k, cache_mem_v, page_table, mem_prompt, w_in, b_if, w_mlstm_norm,
              lambda_q1, lambda_k1, lambda_q2, lambda_k2, w_diff_norm, w_mem_kv, w_out, ln_g, ln_b):
    f32 = jnp.float32
    bp, lp = x_prompt.shape[:2]
    bd, ls = x_sample.shape[:2]
    past_len = page_table.shape[1] * cache_diff_k.shape[2]
    pos_p = jnp.arange(lp)
    pos_s = past_len + jnp.arange(ls)
    k_pos_s = jnp.arange(past_len + ls)
    hp, hs = x_prompt, x_sample
    p_c, p_n, p_m, p_k, p_v, p_mk, p_mv = [], [], [], [], [], [], []
    s_c, s_n, s_m, s_k, s_v = [], [], [], [], []
    for l in range(DEPTH):
        lam_init = 0.8 - 0.6 * math.exp(-0.3 * l)
        lam = (jnp.exp(jnp.sum(lambda_q1[l].astype(f32) * lambda_k1[l].astype(f32)))
               - jnp.exp(jnp.sum(lambda_q2[l].astype(f32) * lambda_k2[l].astype(f32))) + lam_init)

        q_m, k_m, v_m, ig, lf, mo, dq, dk, dv, cq, gate = branch_inputs(hp, pos_p, w_in[l], b_if[l])
        c0 = jnp.zeros((bp, H_M, DH_M, DH_M), f32)
        n0 = jnp.zeros((bp, H_M, DH_M), f32)
        m0 = jnp.zeros((bp, H_M), f32)
        h_m, c_f, n_f, m_f = mlstm_chunkwise(q_m, k_m, v_m, ig, lf, c0, n0, m0)
        h_m = mlstm_readout(h_m, mo, w_mlstm_norm[l])
        h_d = diff_post(diff_attention_prompt(dq, dk, dv, lam), w_diff_norm[l], lam_init)
        mk, mv = memory_kv(mem_prompt, w_mem_kv[l])
        h_c = memory_attend(cq, mk, mv)
        hp_next = merge_output(hp, h_m, h_d, h_c, gate, w_out[l], ln_g[l], ln_b[l])
        p_c.append(c_f)
        p_n.append(n_f)
        p_m.append(m_f)
        p_k.append(dk.reshape(bp, lp, H_D, 2 * DQK_D))
        p_v.append(dv)
        p_mk.append(mk)
        p_mv.append(mv)

        q_m, k_m, v_m, ig, lf, mo, dq, dk, dv, cq, gate = branch_inputs(hs, pos_s, w_in[l], b_if[l])
        h_m, c_f, n_f, m_f = mlstm_chunkwise(q_m, k_m, v_m, ig, lf, state_mlstm_c[l].astype(f32),
                                             state_mlstm_n[l].astype(f32), state_mlstm_m[l].astype(f32))
        h_m = mlstm_readout(h_m, mo, w_mlstm_norm[l])
        past_k = cache_diff_k[l][page_table].reshape(bd, past_len, H_D, 2, DQK_D)
        past_v = cache_diff_v[l][page_table].reshape(bd, past_len, H_D, DV_D)
        k_all = jnp.concatenate([past_k, dk.astype(past_k.dtype)], axis=1)
        v_all = jnp.concatenate([past_v, dv.astype(past_v.dtype)], axis=1)
        h_d = diff_post(diff_attend(dq.astype(k_all.dtype), k_all, v_all, lam, pos_s, k_pos_s), w_diff_norm[l], lam_init)
        h_c = memory_attend(cq, cache_mem_k[l].astype(cq.dtype), cache_mem_v[l].astype(cq.dtype))
        hs_next = merge_output(hs, h_m, h_d, h_c, gate, w_out[l], ln_g[l], ln_b[l])
        s_c.append(c_f)
        s_n.append(n_f)
        s_m.append(m_f)
        s_k.append(dk.reshape(bd, ls, H_D, 2 * DQK_D))
        s_v.append(dv)

        hp, hs = hp_next, hs_next

    return (hp, hs,
            jnp.stack(p_c), jnp.stack(p_n), jnp.stack(p_m), jnp.stack(p_k), jnp.stack(p_v),
            jnp.stack(p_mk), jnp.stack(p_mv),
            jnp.stack(s_c), jnp.stack(s_n), jnp.stack(s_m), jnp.stack(s_k), jnp.stack(s_v))
```

```cpp
#include <hip/hip_runtime.h>
#include <cstdio>
#include <cstdint>
#define MK_N_LAUNCHES 6
#include <hip/hip_runtime.h>
#include <cstdio>
#include <cstdint>
namespace pg8 {
#define PG8_LAS __attribute__((address_space(3)))
typedef unsigned short bf16_t;
typedef short bf16x8 __attribute__((ext_vector_type(8)));
typedef float f32x4 __attribute__((ext_vector_type(4)));
typedef unsigned u32x4 __attribute__((ext_vector_type(4)));
constexpr int BM = 256, BK = 64, HALF = 128, HTB = HALF * BK * 2  , STAGE_BYTES = 8 * HTB, NXCD = 8, WGM = 8;

__host__ __device__ __forceinline__ int lds_byte(int r, int c) { const int st = (r >> 4) * 2 + (c >> 5), rr = r & 15, cc = c & 31, ob = rr * 64 + cc * 2; return st * 1024 + (ob ^ (((ob >> 9) & 1) << 5)); }
__host__ __device__ __forceinline__ void stage_rc(int b, int& R, int& C) { const int st = b / 1024, sb = b % 1024, swz = sb ^ (((sb >> 9) & 1) << 5); R = (st >> 1) * 16 + swz / 64; C = (st & 1) * 32 + (swz % 64) / 2; }
__host__ __device__ __forceinline__ int perm32(int rho) { const int n = rho >> 4, i = rho & 15; return 8 * (i >> 2) + 4 * n + (i & 3); }

struct Unit { int pm, pn; };
struct Gemm { const bf16_t* A; const bf16_t* Bt; int M, N, K; };

struct StaticOrder {
    int nM, nN, nwg, G, c;
    __host__ __device__ void init(int M, int N, int G_, int c_) { nM = M / BM; nN = N / BM; nwg = nM * nN; G = G_; c = c_; }
    __host__ __device__ bool next(int i, Unit& u) const {
        const long L = (long)i * G + c; if (L >= nwg) return false;
        int wgid = (int)L; { const int q = nwg / NXCD, r = nwg % NXCD, xcd = wgid % NXCD, off = wgid / NXCD; wgid = (xcd < r ? xcd * (q + 1) : r * (q + 1) + (xcd - r) * q) + off; }
        const int nig = WGM * nN, gid = wgid / nig, fm = gid * WGM, gsz = (nM - fm) < WGM ? (nM - fm) : WGM;
        u.pm = fm + ((wgid % nig) % gsz); u.pn = (wgid % nig) / gsz; return true;
    }
    __device__ __forceinline__ void a_ready(const Unit&) const {}
    __device__ __forceinline__ void done(const Unit&) const {}
};

__device__ __forceinline__ unsigned cvt_pk_bf16(float lo, float hi) { unsigned r; asm volatile("v_cvt_pk_bf16_f32 %0, %1, %2" : "=v"(r) : "v"(lo), "v"(hi)); return r; }
typedef float f32x2 __attribute__((ext_vector_type(2)));
__device__ __forceinline__ f32x2 gelu_pk(f32x2 v) {
    const f32x2 av = __builtin_elementwise_abs(v), d = av * 0.2316418882f + 1.0f;
    f32x2 t; t.x = __builtin_amdgcn_rcpf(d.x); t.y = __builtin_amdgcn_rcpf(d.y);
    f32x2 q = t * 0.5307027145f + (-0.7265760135f); q = q * t + 0.7107068705f; q = q * t + (-0.142248368f); q = q * t + 0.127414796f; q = q * t;
    const f32x2 s = (v * v) * (-0.72134752044f);
    f32x2 e; e.x = __builtin_amdgcn_exp2f(s.x); e.y = __builtin_amdgcn_exp2f(s.y);
    const f32x2 m = v * (q * e), r = v - m;
    f32x2 o; o.x = v.x < 0.f ? m.x : r.x; o.y = v.y < 0.f ? m.y : r.y; return o;
}

template <int ACT  > struct EpiBf16 {
    static constexpr bool PERM = true, AFTER_DRAIN = false; static_assert(ACT == 0 || ACT == 1, "EpiBf16: ACT is 0 (none) or 1 (gelu_pk)");
    bf16_t* O; int ldc; const float* bias; int split_cols; size_t split_stride; float scale0;
    __device__ __forceinline__ void operator()(const f32x4 (&acc)[2][2][4][2], const Unit& u, int wr, int wc, int fr, int fq) const {
        const int row0 = u.pm * BM + wr * 64 + fr; int colt = u.pn * BM; bf16_t* base = O;
        float sc = 1.f; if (split_cols) { const int t = colt / split_cols; base += (size_t)t * split_stride; colt -= t * split_cols; if (t == 0) sc = scale0; }
        const int col0 = colt + wc * 32 + 8 * fq, bcol0 = u.pn * BM + wc * 32 + 8 * fq;
        f32x4 bv[2][2];
#pragma unroll
        for (int bj = 0; bj < 2; ++bj)
#pragma unroll
            for (int n = 0; n < 2; ++n) bv[bj][n] = bias ? *(const f32x4*)(bias + bcol0 + bj * HALF + 4 * n) : (f32x4){0.f, 0.f, 0.f, 0.f};
#pragma unroll
        for (int ai = 0; ai < 2; ++ai)
#pragma unroll
            for (int m = 0; m < 4; ++m) { bf16_t* rowp = base + (size_t)(row0 + ai * HALF + m * 16) * ldc + col0;
#pragma unroll
                for (int bj = 0; bj < 2; ++bj) { f32x4 v0 = acc[ai][bj][m][0] + bv[bj][0], v1 = acc[ai][bj][m][1] + bv[bj][1];
                    if (ACT == 1) { f32x2 a = gelu_pk((f32x2){v0[0], v0[1]}), b = gelu_pk((f32x2){v0[2], v0[3]}), c = gelu_pk((f32x2){v1[0], v1[1]}), d = gelu_pk((f32x2){v1[2], v1[3]});
                        v0 = (f32x4){a.x, a.y, b.x, b.y}; v1 = (f32x4){c.x, c.y, d.x, d.y}; }
                    v0 = v0 * sc; v1 = v1 * sc; u32x4 w; w.x = cvt_pk_bf16(v0[0], v0[1]); w.y = cvt_pk_bf16(v0[2], v0[3]); w.z = cvt_pk_bf16(v1[0], v1[1]); w.w = cvt_pk_bf16(v1[2], v1[3]);
                    *(u32x4*)(rowp + bj * HALF) = w; } }
    }
};

struct PanelStats {
    unsigned* xbuf;
    unsigned* cnt;
    unsigned* tmo;
    int ntn; float eps;
    unsigned code;
    __device__ __forceinline__ bool run(const f32x4 (&v)[2][2][4][2], const Unit& u, int wr, int wc, int fr, int fq, PG8_LAS unsigned char* lds, int wid, int lane) const {
        typedef float f32x2v __attribute__((ext_vector_type(2)));
        PG8_LAS f32x2v* P = (PG8_LAS f32x2v*)lds;
        PG8_LAS f32x2v* S = (PG8_LAS f32x2v*)(lds + 8192);
        PG8_LAS unsigned* flag = (PG8_LAS unsigned*)(lds + 8192 + 2048);
#pragma unroll
        for (int ai = 0; ai < 2; ++ai)
#pragma unroll
            for (int m = 0; m < 4; ++m) {
                float s = 0.f;
#pragma unroll
                for (int bj = 0; bj < 2; ++bj)
#pragma unroll
                    for (int n = 0; n < 2; ++n) { const f32x4 x = v[ai][bj][m][n]; s += (x[0] + x[1]) + (x[2] + x[3]); }
                s += __shfl_xor(s, 16); s += __shfl_xor(s, 32);
                const float mw = s * (1.0f / 64.0f); float q = 0.f;
#pragma unroll
                for (int bj = 0; bj < 2; ++bj)
#pragma unroll
                    for (int n = 0; n < 2; ++n) { const f32x4 d = v[ai][bj][m][n] - mw; q += (d[0] * d[0] + d[1] * d[1]) + (d[2] * d[2] + d[3] * d[3]); }
                q += __shfl_xor(q, 16); q += __shfl_xor(q, 32);
                if (fq == 0) P[(ai * HALF + wr * 64 + m * 16 + fr) * 4 + wc] = (f32x2v){mw, q};
            }
        asm volatile("s_waitcnt lgkmcnt(0)" ::: "memory"); __builtin_amdgcn_s_barrier(); asm volatile("" ::: "memory");
#if defined(BROKEN_EXCHANGE_NO_WAIT)
#warning BROKEN CONTROL BUILD: the row-statistics exchange does not wait; results are wrong by design
        if (blockIdx.x >= 64) { const long long t0_ = clock64(); while (clock64() - t0_ < 60000) __builtin_amdgcn_s_sleep(8); }
#endif
        const int row = wid * 32 + (lane & 31);
        if (lane < 32) {
            const f32x2v a = P[row * 4 + 0], b = P[row * 4 + 1], c = P[row * 4 + 2], d = P[row * 4 + 3];
            const float mt = (a.x + b.x + c.x + d.x) * 0.25f;
            const float da = a.x - mt, db = b.x - mt, dc = c.x - mt, dd = d.x - mt;
            const float m2 = (a.y + b.y) + (c.y + d.y) + 64.0f * ((da * da + db * db) + (dc * dc + dd * dd));
            unsigned long long* slot = (unsigned long long*)xbuf + ((size_t)(u.pm * BM + row) * 4 + u.pn);
            __hip_atomic_store(slot, ((unsigned long long)__float_as_uint(m2) << 32) | __float_as_uint(mt), __ATOMIC_RELAXED, __HIP_MEMORY_SCOPE_AGENT);
        }
        asm volatile("s_waitcnt vmcnt(0)" ::: "memory");
        if (lane == 0) __hip_atomic_fetch_add(cnt + 64 * u.pm, 1u, __ATOMIC_RELAXED, __HIP_MEMORY_SCOPE_AGENT);
        if (wid == 0) {
            bool dead = false; const unsigned long long t0 = __builtin_amdgcn_s_memrealtime(); const unsigned want = 8u * (unsigned)ntn;
            for (;;) {
#if defined(BROKEN_EXCHANGE_NO_WAIT)
                break;
#endif
                if ((unsigned)__builtin_amdgcn_readfirstlane(__hip_atomic_load(cnt + 64 * u.pm, __ATOMIC_RELAXED, __HIP_MEMORY_SCOPE_AGENT)) >= want) break;
                if (__builtin_amdgcn_s_memrealtime() - t0 > 2000000ull) {
                    if (lane == 0) { unsigned expect = 0u; __hip_atomic_compare_exchange_strong(tmo + 1, &expect, code | (unsigned)(u.pm & 0xff), __ATOMIC_RELAXED, __ATOMIC_RELAXED, __HIP_MEMORY_SCOPE_AGENT);
                                     __hip_atomic_store(tmo, 1u, __ATOMIC_RELAXED, __HIP_MEMORY_SCOPE_AGENT); }
                    dead = true; break; }
                __builtin_amdgcn_s_sleep(2);
            }
            __builtin_amdgcn_fence(__ATOMIC_ACQUIRE, "agent");
            if (lane == 0) flag[0] = dead ? 1u : 0u;
        }
        asm volatile("s_waitcnt vmcnt(0) lgkmcnt(0)" ::: "memory"); __builtin_amdgcn_s_barrier(); asm volatile("" ::: "memory");
        const bool bad = flag[0] != 0u;
        if (lane < 32) {
            const unsigned long long* slot = (const unsigned long long*)xbuf + (size_t)(u.pm * BM + row) * 4; float mt[4], m2[4]; float ms = 0.f;
#pragma unroll
            for (int t = 0; t < 4; ++t) { if (t < ntn) { const unsigned long long w = __hip_atomic_load(slot + t, __ATOMIC_RELAXED, __HIP_MEMORY_SCOPE_AGENT); mt[t] = __uint_as_float((unsigned)w); m2[t] = __uint_as_float((unsigned)(w >> 32)); } else { mt[t] = 0.f; m2[t] = 0.f; } ms += mt[t]; }
            const float mean = ms / (float)ntn; float q = 0.f;
#pragma unroll
            for (int t = 0; t < 4; ++t) if (t < ntn) { const float dm = mt[t] - mean; q += m2[t] + 256.0f * dm * dm; }
            S[row] = (f32x2v){mean, 1.0f / sqrtf(q / (256.0f * (float)ntn) + eps)};
        }
        asm volatile("s_waitcnt lgkmcnt(0)" ::: "memory"); __builtin_amdgcn_s_barrier(); asm volatile("" ::: "memory");
        return bad;
    }
};
struct EpiLnRes {
    static constexpr bool PERM = false, AFTER_DRAIN = true;
    const float* base; float* out; int ldc; const float* bias; PanelStats st; unsigned poison;
    __device__ __forceinline__ void fused(f32x4 (&acc)[2][2][4][2], const Unit& u, int wr, int wc, int fr, int fq, PG8_LAS unsigned char* lds, int wid, int lane) const {
        typedef float f32x2v __attribute__((ext_vector_type(2)));
        const PG8_LAS f32x2v* S = (const PG8_LAS f32x2v*)(lds + 8192);
        const int col0 = u.pn * BM + wc * 32 + 4 * fq;
#pragma unroll
        for (int bj = 0; bj < 2; ++bj)
#pragma unroll
            for (int n = 0; n < 2; ++n) { const f32x4 bv = bias ? *(const f32x4*)(bias + col0 + bj * HALF + n * 16) : (f32x4){0.f, 0.f, 0.f, 0.f};
#pragma unroll
                for (int ai = 0; ai < 2; ++ai)
#pragma unroll
                    for (int m = 0; m < 4; ++m) acc[ai][bj][m][n] += bv; }
        f32x4 pre[4][2][2];
#pragma unroll
        for (int m = 0; m < 4; ++m) { const size_t off = (size_t)(u.pm * BM + wr * 64 + m * 16 + fr) * ldc + col0;
#pragma unroll
            for (int bj = 0; bj < 2; ++bj)
#pragma unroll
                for (int n = 0; n < 2; ++n) pre[m][bj][n] = *(const f32x4*)(base + off + bj * HALF + n * 16); }
        const bool bad = st.run(acc, u, wr, wc, fr, fq, lds, wid, lane) || poison != 0u;
        const float qnan = __builtin_nanf("");
#pragma unroll
        for (int ai = 0; ai < 2; ++ai)
#pragma unroll
            for (int m = 0; m < 4; ++m) { const int r = ai * HALF + wr * 64 + m * 16 + fr; const f32x2v sr = S[r]; const size_t off = (size_t)(u.pm * BM + r) * ldc + col0;
#pragma unroll
                for (int bj = 0; bj < 2; ++bj)
#pragma unroll
                    for (int n = 0; n < 2; ++n) { const f32x4 bs = ai == 0 ? pre[m][bj][n] : *(const f32x4*)(base + off + bj * HALF + n * 16); f32x4 o = bs + (acc[ai][bj][m][n] - sr.x) * sr.y;
                        if (bad) o = (f32x4){qnan, qnan, qnan, qnan}; *(f32x4*)(out + off + bj * HALF + n * 16) = o; }
                if (m & 1) asm volatile("" ::: "memory"); }
    }
};
struct EpiLnResLn {
    static constexpr bool PERM = false, AFTER_DRAIN = true;
    const float* base; float* out; bf16_t* xn; int ldc; const float* bias; PanelStats st1, st2; unsigned poison;
    __device__ __forceinline__ void fused(f32x4 (&acc)[2][2][4][2], const Unit& u, int wr, int wc, int fr, int fq, PG8_LAS unsigned char* lds, int wid, int lane) const {
        typedef float f32x2v __attribute__((ext_vector_type(2))); typedef unsigned u32x2v __attribute__((ext_vector_type(2)));
        const PG8_LAS f32x2v* S = (const PG8_LAS f32x2v*)(lds + 8192);
        const int col0 = u.pn * BM + wc * 32 + 4 * fq;
#pragma unroll
        for (int bj = 0; bj < 2; ++bj)
#pragma unroll
            for (int n = 0; n < 2; ++n) { const f32x4 bv = bias ? *(const f32x4*)(bias + col0 + bj * HALF + n * 16) : (f32x4){0.f, 0.f, 0.f, 0.f};
#pragma unroll
                for (int ai = 0; ai < 2; ++ai)
#pragma unroll
                    for (int m = 0; m < 4; ++m) acc[ai][bj][m][n] += bv; }
        bool bad = st1.run(acc, u, wr, wc, fr, fq, lds, wid, lane) || poison != 0u;
        const float qnan = __builtin_nanf("");
#pragma unroll
        for (int ai = 0; ai < 2; ++ai)
#pragma unroll
            for (int m = 0; m < 4; ++m) { const int r = ai * HALF + wr * 64 + m * 16 + fr; const f32x2v sr = S[r]; const size_t off = (size_t)(u.pm * BM + r) * ldc + col0;
#pragma unroll
                for (int bj = 0; bj < 2; ++bj)
#pragma unroll
                    for (int n = 0; n < 2; ++n) { const f32x4 bs = *(const f32x4*)(base + off + bj * HALF + n * 16); acc[ai][bj][m][n] = bs + (acc[ai][bj][m][n] - sr.x) * sr.y; }
                asm volatile("" : "+v"(acc[ai][0][m][0]), "+v"(acc[ai][0][m][1]), "+v"(acc[ai][1][m][0]), "+v"(acc[ai][1][m][1]));
                if (m & 1) asm volatile("" ::: "memory"); }
        const bool bad1 = bad;
        bad = st2.run(acc, u, wr, wc, fr, fq, lds, wid, lane) || bad;
#pragma unroll
        for (int ai = 0; ai < 2; ++ai)
#pragma unroll
            for (int m = 0; m < 4; ++m) { const int r = ai * HALF + wr * 64 + m * 16 + fr; const f32x2v sr = S[r]; const size_t off = (size_t)(u.pm * BM + r) * ldc + col0;
#pragma unroll
                for (int bj = 0; bj < 2; ++bj)
#pragma unroll
                    for (int n = 0; n < 2; ++n) { const f32x4 x1 = acc[ai][bj][m][n]; *(f32x4*)(out + off + bj * HALF + n * 16) = bad1 ? (f32x4){qnan, qnan, qnan, qnan} : x1;
                        const f32x4 o = (x1 - sr.x) * sr.y; u32x2v w; w.x = cvt_pk_bf16(o[0], o[1]); w.y = cvt_pk_bf16(o[2], o[3]);
                        if (bad) { w.x = 0x7fc07fc0u; w.y = 0x7fc07fc0u; } *(u32x2v*)(xn + off + bj * HALF + n * 16) = w; }
                asm volatile("" ::: "memory"); }
    }
};

template <class Epi, class Sched, bool ALIGN_EPI = false, bool SP2 = false>
__device__ __forceinline__ void gemm_phase(PG8_LAS unsigned char* lds, const Gemm g, const Sched& S, const Epi& E) {
    const int tid = threadIdx.x, wid = __builtin_amdgcn_readfirstlane(tid >> 6), lane = tid & 63, wr = wid >> 2, wc = wid & 3, fr = lane & 15, fq = lane >> 4;
    const int K = g.K, nt = K / BK;
    unsigned voffA[2], voffB[2];
#pragma unroll
    for (int i = 0; i < 2; ++i) { int R, C; stage_rc(tid * 16 + i * 8192, R, C); const int Rb = Epi::PERM ? ((R & ~31) + perm32(R & 31)) : R;
        voffA[i] = (unsigned)(R * K + C) * 2u; voffB[i] = (unsigned)(Rb * K + C) * 2u; }
    const size_t kstep = (size_t)(BK * 2);
    const size_t hstep = (size_t)HALF * K * 2;
    const size_t tstep = 2 * hstep;
    const unsigned ldsw = (unsigned)wid * 1024u;
    const int aoff = lds_byte(wr * 64 + fr, fq * 8), boff = lds_byte(wc * 32 + fr, fq * 8);
#define PG8_SA(b, h) (((b) * 2 + (h)) * HTB)
#define PG8_SB(b, h) ((4 + (b) * 2 + (h)) * HTB)
#define PG8_STAGE(bufoff, gbase, voff) do { _Pragma("unroll") for (int _i = 0; _i < 2; ++_i) \
        __builtin_amdgcn_global_load_lds((const unsigned*)((const char*)(gbase) + (voff)[_i]), (PG8_LAS unsigned*)(lds + (bufoff) + ldsw + _i * 8192), 16, 0, 0); } while (0)
#define PG8_LDA(dst, b, h) do { _Pragma("unroll") for (int m = 0; m < 4; ++m) _Pragma("unroll") for (int k = 0; k < 2; ++k) dst[m][k] = *(const PG8_LAS bf16x8*)(lds + PG8_SA(b, h) + aoff + m * 2048 + k * 1024); } while (0)
#define PG8_LDB(dst, b, h) do { _Pragma("unroll") for (int n = 0; n < 2; ++n) _Pragma("unroll") for (int k = 0; k < 2; ++k) dst[n][k] = *(const PG8_LAS bf16x8*)(lds + PG8_SB(b, h) + boff + n * 2048 + k * 1024); } while (0)
#define PG8_MMA(ai, bj, At, Bt) do { __builtin_amdgcn_s_setprio(1); _Pragma("unroll") for (int m = 0; m < 4; ++m) _Pragma("unroll") for (int n = 0; n < 2; ++n) _Pragma("unroll") for (int k = 0; k < 2; ++k) \
        acc[ai][bj][m][n] = __builtin_amdgcn_mfma_f32_16x16x32_bf16(Bt[n][k], At[m][k], acc[ai][bj][m][n], 0, 0, 0); __builtin_amdgcn_s_setprio(0); } while (0)
#define PG8_WAIT_V(n) asm volatile("s_waitcnt vmcnt(" #n ")" ::: "memory")
#define PG8_WAIT_L(n) asm volatile("s_waitcnt lgkmcnt(" #n ")" ::: "memory")
#define PG8_BAR __builtin_amdgcn_s_barrier()
#define PG8_SCHED __builtin_amdgcn_sched_barrier(0)
    Unit cur, nxt; int ui = 0;
    if (!S.next(0, cur)) return;
    f32x4 acc[2][2][4][2];
#pragma unroll
    for (int a = 0; a < 2; ++a)
#pragma unroll
        for (int b = 0; b < 2; ++b)
#pragma unroll
            for (int m = 0; m < 4; ++m)
#pragma unroll
                for (int n = 0; n < 2; ++n) acc[a][b][m][n] = (f32x4){0.f, 0.f, 0.f, 0.f};
    bf16x8 At[4][2], B0[2][2], B1[2][2];
    const char* cA = (const char*)g.A + (size_t)cur.pm * tstep; const char* cB = (const char*)g.Bt + (size_t)cur.pn * tstep;
    S.a_ready(cur);
    if constexpr (SP2) {
        PG8_STAGE(PG8_SB(0, 0), cB, voffB); PG8_STAGE(PG8_SB(0, 1), cB + hstep, voffB); PG8_STAGE(PG8_SA(0, 0), cA, voffA); PG8_STAGE(PG8_SA(0, 1), cA + hstep, voffA);
        if (wr == 1) PG8_BAR;
        PG8_WAIT_V(2); PG8_BAR;
        PG8_STAGE(PG8_SB(1, 0), cB + kstep, voffB); PG8_STAGE(PG8_SA(1, 0), cA + kstep, voffA); PG8_STAGE(PG8_SB(1, 1), cB + hstep + kstep, voffB);
        PG8_WAIT_V(6); PG8_BAR;
    } else {
        PG8_STAGE(PG8_SB(0, 0), cB, voffB); PG8_STAGE(PG8_SA(0, 0), cA, voffA); PG8_STAGE(PG8_SB(0, 1), cB + hstep, voffB); PG8_STAGE(PG8_SA(0, 1), cA + hstep, voffA);
        if (wr == 1) PG8_BAR;
        PG8_WAIT_V(4); PG8_BAR;
        PG8_STAGE(PG8_SB(1, 0), cB + kstep, voffB); PG8_STAGE(PG8_SA(1, 0), cA + kstep, voffA); PG8_STAGE(PG8_SB(1, 1), cB + hstep + kstep, voffB);
        PG8_WAIT_V(6); PG8_BAR;
    }
    for (;;) {
        const bool has_next = S.next(ui + 1, nxt);
        const char* nA = has_next ? (const char*)g.A + (size_t)nxt.pm * tstep : cA; const char* nB = has_next ? (const char*)g.Bt + (size_t)nxt.pn * tstep : cB;
        for (int t = 0; t < nt; t += 2) {
            const bool last = (t == nt - 2);
            const char* a1 = cA + (size_t)(t + 1) * kstep;
            const char* a2 = last ? nA : cA + (size_t)(t + 2) * kstep; const char* b2 = last ? nB : cB + (size_t)(t + 2) * kstep;
            const char* a3 = a2 + kstep; const char* b3 = b2 + kstep;
            if (last && has_next) S.a_ready(nxt);
            if constexpr (SP2) {
            PG8_LDB(B0, 0, 0); PG8_LDB(B1, 0, 1); PG8_SCHED; PG8_LDA(At, 0, 0); PG8_STAGE(PG8_SA(1, 1), a1 + hstep, voffA);
            PG8_WAIT_V(8); PG8_WAIT_L(0); PG8_BAR; PG8_MMA(0, 0, At, B0); PG8_MMA(0, 1, At, B1); PG8_BAR; PG8_SCHED;
            PG8_LDA(At, 0, 1); PG8_STAGE(PG8_SB(0, 0), b2, voffB); PG8_STAGE(PG8_SB(0, 1), b2 + hstep, voffB); PG8_STAGE(PG8_SA(0, 0), a2, voffA);
            PG8_WAIT_V(8); PG8_WAIT_L(0); PG8_BAR; PG8_MMA(1, 0, At, B0); PG8_MMA(1, 1, At, B1); PG8_BAR; PG8_SCHED;
            PG8_LDB(B0, 1, 0); PG8_LDB(B1, 1, 1); PG8_SCHED; PG8_LDA(At, 1, 0); PG8_STAGE(PG8_SA(0, 1), a2 + hstep, voffA);
            PG8_WAIT_V(8); PG8_WAIT_L(0); PG8_BAR; PG8_MMA(0, 0, At, B0); PG8_MMA(0, 1, At, B1); PG8_BAR; PG8_SCHED;
            PG8_LDA(At, 1, 1); PG8_STAGE(PG8_SB(1, 0), b3, voffB); PG8_STAGE(PG8_SB(1, 1), b3 + hstep, voffB); PG8_STAGE(PG8_SA(1, 0), a3, voffA);
            PG8_WAIT_V(8); PG8_WAIT_L(0); PG8_BAR; PG8_MMA(1, 0, At, B0); PG8_MMA(1, 1, At, B1); PG8_BAR; PG8_SCHED;
            } else {
            PG8_LDB(B0, 0, 0); PG8_SCHED; PG8_LDA(At, 0, 0); PG8_STAGE(PG8_SA(1, 1), a1 + hstep, voffA);
            PG8_WAIT_L(8); PG8_BAR; PG8_WAIT_L(0); PG8_MMA(0, 0, At, B0); PG8_BAR; PG8_SCHED;
            PG8_LDB(B1, 0, 1); PG8_STAGE(PG8_SB(0, 0), b2, voffB);
            PG8_BAR; PG8_WAIT_L(0); PG8_MMA(0, 1, At, B1); PG8_BAR;
            PG8_LDA(At, 0, 1); PG8_STAGE(PG8_SA(0, 0), a2, voffA);
            PG8_BAR; PG8_WAIT_L(0); PG8_MMA(1, 0, At, B0); PG8_BAR; PG8_SCHED;
            PG8_STAGE(PG8_SB(0, 1), b2 + hstep, voffB);
            PG8_WAIT_V(6); PG8_BAR; PG8_MMA(1, 1, At, B1); PG8_BAR;
            PG8_LDB(B0, 1, 0); PG8_SCHED; PG8_LDA(At, 1, 0); PG8_STAGE(PG8_SA(0, 1), a2 + hstep, voffA);
            PG8_WAIT_L(8); PG8_BAR; PG8_WAIT_L(0); PG8_MMA(0, 0, At, B0); PG8_BAR; PG8_SCHED;
            PG8_LDB(B1, 1, 1); PG8_STAGE(PG8_SB(1, 0), b3, voffB);
            PG8_BAR; PG8_WAIT_L(0); PG8_MMA(0, 1, At, B1); PG8_BAR;
            PG8_LDA(At, 1, 1); PG8_STAGE(PG8_SA(1, 0), a3, voffA);
            PG8_BAR; PG8_WAIT_L(0); PG8_MMA(1, 0, At, B0); PG8_BAR; PG8_SCHED;
            PG8_STAGE(PG8_SB(1, 1), b3 + hstep, voffB);
            PG8_WAIT_V(6); PG8_BAR; PG8_MMA(1, 1, At, B1); PG8_BAR;
            }
        }
        if constexpr (ALIGN_EPI) { if (wr == 0) PG8_BAR; }
        if constexpr (!Epi::AFTER_DRAIN) { E(acc, cur, wr, wc, fr, fq); S.done(cur); }
        if (!has_next) break;
#pragma unroll
        for (int a = 0; a < 2; ++a)
#pragma unroll
            for (int b = 0; b < 2; ++b)
#pragma unroll
                for (int m = 0; m < 4; ++m)
#pragma unroll
                    for (int n = 0; n < 2; ++n) acc[a][b][m][n] = (f32x4){0.f, 0.f, 0.f, 0.f};
        cur = nxt; cA = nA; cB = nB; ++ui;
        if constexpr (ALIGN_EPI) { if (wr == 1) PG8_BAR; }
    }
    PG8_WAIT_V(0);
    if constexpr (!ALIGN_EPI) { if (wr == 0) PG8_BAR; }
    PG8_BAR;
    if constexpr (Epi::AFTER_DRAIN) { E.fused(acc, cur, wr, wc, fr, fq, lds, wid, lane); S.done(cur); }
#undef PG8_SA
#undef PG8_SB
#undef PG8_STAGE
#undef PG8_LDA
#undef PG8_LDB
#undef PG8_MMA
#undef PG8_WAIT_V
#undef PG8_WAIT_L
#undef PG8_BAR
#undef PG8_SCHED
}
}
#ifndef PG8_SP2
#define PG8_SP2 true
#endif
#ifndef PG8_ALIGN
#define PG8_ALIGN true
#endif
#include <hip/hip_bf16.h>
#include <cmath>
namespace attn_body {
using bf16=__hip_bfloat16;
using bf16x8=__attribute__((ext_vector_type(8)))short;
using s16x4=__attribute__((ext_vector_type(4)))short;
using f32x16=__attribute__((ext_vector_type(16)))float;
using u32x4=__attribute__((ext_vector_type(4)))unsigned;
constexpr int SEQ=2048,D=64,PQ=512,PO=1024;
constexpr int NW=8,QBLK=32,QB=QBLK*NW,KVBLK=64,NQB=SEQ/QB;
constexpr int ATTN_UNIT_ROWS=QB;
__device__ __forceinline__ int crow(int r,int hi){return (r&3)+8*(r>>2)+4*hi;}
#define SBAR() __builtin_amdgcn_sched_barrier(0)
__device__ __forceinline__ void cmask(f32x16&p0,f32x16&p1,int jb,int qrel,int hi){
  const float NEG=-INFINITY; int kb=64*jb+4*hi;
  #pragma unroll
  for(int r=0;r<16;++r){int kv=kb+(r&3)+8*(r>>2); if(kv>qrel)p0[r]=NEG; if(kv+32>qrel)p1[r]=NEG;}
}

constexpr int NSLOT=3, SLOTB=8192;
constexpr int LDS_K=0, LDS_V=NSLOT*SLOTB, LDS_WS=2*NSLOT*SLOTB, LDS_OST=LDS_WS+NW*64*4, LDS_BYTES=LDS_OST+NW*4096;
constexpr float C2=0.125f*1.4426950408889634f;
__device__ __forceinline__ void glds16(const void*gsrc,unsigned lds_dst){unsigned keep;
  asm volatile("s_mov_b32 %0, m0\n\ts_mov_b32 m0, %2\n\ts_nop 0\n\tglobal_load_lds_dwordx4 %1, off\n\ts_mov_b32 m0, %0":"=&s"(keep):"v"(gsrc),"s"(lds_dst):"memory");}
__device__ __forceinline__ float max3f(float a,float b,float c){float r;asm("v_max3_f32 %0, %1, %2, %3":"=v"(r):"v"(a),"v"(b),"v"(c));return r;}
__device__ __forceinline__ float max2f(float a,float b){float r;asm("v_max_f32_e32 %0, %1, %2":"=v"(r):"v"(a),"v"(b));return r;}
__device__ __forceinline__ float fadd_s(float a,float b){float r;asm("v_add_f32_e32 %0, %1, %2":"=v"(r):"v"(a),"v"(b));return r;}
__device__ __forceinline__ float fsub_s(float a,float b){float r;asm("v_sub_f32_e32 %0, %1, %2":"=v"(r):"v"(a),"v"(b));return r;}
typedef float f32x2_t __attribute__((ext_vector_type(2))); typedef __bf16 bf16x2_t __attribute__((ext_vector_type(2)));
__device__ __forceinline__ unsigned cvtpk_s(float lo,float hi){f32x2_t v={lo,hi};bf16x2_t b=__builtin_convertvector(v,bf16x2_t);return __builtin_bit_cast(unsigned,b);}
#define WAIT_BAR(N) asm volatile("s_waitcnt vmcnt(" #N ") lgkmcnt(0)\n\ts_barrier":::"memory")

__device__ __forceinline__ void qkt(f32x16&p0,f32x16&p1,const char*Kslot,const bf16x8*qr,const f32x16&negm,int r32,int hi){
  const char*kb=Kslot+hi*1024+r32*16;
  #pragma unroll
  for(int d0=0;d0<4;++d0){
    const bf16x8 b0=*reinterpret_cast<const bf16x8*>(kb+d0*2048);
    const bf16x8 b1=*reinterpret_cast<const bf16x8*>(kb+d0*2048+512);
    if(d0==0){p0=__builtin_amdgcn_mfma_f32_32x32x16_bf16(b0,qr[0],negm,0,0,0);p1=__builtin_amdgcn_mfma_f32_32x32x16_bf16(b1,qr[0],negm,0,0,0);}
    else{p0=__builtin_amdgcn_mfma_f32_32x32x16_bf16(b0,qr[d0],p0,0,0,0);p1=__builtin_amdgcn_mfma_f32_32x32x16_bf16(b1,qr[d0],p1,0,0,0);}}
}
typedef __attribute__((address_space(3))) const char* lds_cptr;
typedef short v4i16_t __attribute__((ext_vector_type(4)));
__device__ __forceinline__ void kload8(bf16x8*kf,lds_cptr kp){
  kf[0]=*(const __attribute__((address_space(3))) bf16x8*)(kp);      kf[1]=*(const __attribute__((address_space(3))) bf16x8*)(kp+512);
  kf[2]=*(const __attribute__((address_space(3))) bf16x8*)(kp+2048); kf[3]=*(const __attribute__((address_space(3))) bf16x8*)(kp+2560);
  kf[4]=*(const __attribute__((address_space(3))) bf16x8*)(kp+4096); kf[5]=*(const __attribute__((address_space(3))) bf16x8*)(kp+4608);
  kf[6]=*(const __attribute__((address_space(3))) bf16x8*)(kp+6144); kf[7]=*(const __attribute__((address_space(3))) bf16x8*)(kp+6656);
}
__device__ __forceinline__ void kload2(bf16x8*kf,lds_cptr kp,int j){ kf[2*j]=*(const __attribute__((address_space(3))) bf16x8*)(kp+j*2048); kf[2*j+1]=*(const __attribute__((address_space(3))) bf16x8*)(kp+j*2048+512); }
__device__ __forceinline__ s16x4 vtr(lds_cptr p){ return __builtin_bit_cast(s16x4,__builtin_amdgcn_ds_read_tr16_b64_v4i16((__attribute__((address_space(3))) v4i16_t*)p)); }
__device__ __forceinline__ float rowmax(const f32x16&p0,const f32x16&p1){
  float a=max3f(p0[0],p0[1],p1[0]),b=max3f(p0[2],p0[3],p1[1]);a=max3f(a,p1[2],p1[3]);
  #pragma unroll
  for(int r=4;r<16;r+=4){a=max3f(a,p0[r],p0[r+1]);b=max3f(b,p0[r+2],p0[r+3]);a=max3f(a,p1[r],p1[r+1]);b=max3f(b,p1[r+2],p1[r+3]);}
  const float m=max2f(a,b);
  auto rr=__builtin_amdgcn_permlane32_swap(__float_as_uint(m),__float_as_uint(m),false,false);
  return max2f(__uint_as_float(rr[0]),__uint_as_float(rr[1]));
}
__device__ __forceinline__ void pv(f32x16*o,int vb,bf16x8 pa0,bf16x8 pa1,bf16x8 pa2,bf16x8 pa3){
  #pragma unroll
  for(int d0=0;d0<2;++d0){s16x4 lo[4],hi[4];
    #pragma unroll
    for(int ks=0;ks<4;++ks){
      asm volatile("ds_read_b64_tr_b16 %0,%1 offset:%c2":"=&v"(lo[ks]):"v"(vb),"i"(d0*4096+ks*1024):"memory");
      asm volatile("ds_read_b64_tr_b16 %0,%1 offset:%c2":"=&v"(hi[ks]):"v"(vb),"i"(d0*4096+ks*1024+512):"memory");}
    asm volatile("s_waitcnt lgkmcnt(0)":::"memory");SBAR();
    #define PK(k) (bf16x8){lo[k][0],lo[k][1],lo[k][2],lo[k][3],hi[k][0],hi[k][1],hi[k][2],hi[k][3]}
    o[d0]=__builtin_amdgcn_mfma_f32_32x32x16_bf16(pa0,PK(0),o[d0],0,0,0);
    o[d0]=__builtin_amdgcn_mfma_f32_32x32x16_bf16(pa1,PK(1),o[d0],0,0,0);
    o[d0]=__builtin_amdgcn_mfma_f32_32x32x16_bf16(pa2,PK(2),o[d0],0,0,0);
    o[d0]=__builtin_amdgcn_mfma_f32_32x32x16_bf16(pa3,PK(3),o[d0],0,0,0);
    #undef PK
  }
}

#ifndef ATTN_STORE16
#define ATTN_STORE16(p,v) (*(u32x4*)(p)=(v))
#endif
template<int THRL> __device__ __forceinline__ void attn_unit(int qb,const bf16*Q,const bf16*__restrict__ K,const bf16*__restrict__ V,bf16*O,char*shm){
  int tid_=threadIdx.x; asm volatile("":"+v"(tid_)); const int tid=tid_,lane=tid&63,r32=lane&31,hi=lane>>5; const int wid=__builtin_amdgcn_readfirstlane(tid>>6);
  const int q0=qb*QB;
  const bf16*Qw=Q+(long)(q0+wid*QBLK)*PQ;
  const bf16*Kh=K,*Vh=V;
  const unsigned lds0=(unsigned)(uintptr_t)shm;
  float*wsf=(float*)(shm+LDS_WS)+wid*64;
  const bf16*ksrc=Kh+(long)lane*PQ+wid*8;
  const bf16*vsrc=Vh+(long)(16*(wid&3)+(lane>>2))*PQ+(wid>>2)*32+(lane&3)*8;
  const unsigned kdst=lds0+LDS_K+wid*1024, vdst=lds0+LDS_V+wid*1024;
  #define DMA_K(t,slot) glds16(ksrc+(long)(t)*KVBLK*PQ,(unsigned)__builtin_amdgcn_readfirstlane(kdst+(slot)))
  #define DMA_V(t,slot) glds16(vsrc+(long)(t)*KVBLK*PQ,(unsigned)__builtin_amdgcn_readfirstlane(vdst+(slot)))
  const int vb0=(int)(lds0+LDS_V)+((lane>>4)&1)*32+(lane&3)*8+(4*hi+((lane&15)>>2))*64;
  const char*Kbase=shm+LDS_K; bf16x8 kf[8];
  const lds_cptr shm3=(lds_cptr)shm; const lds_cptr kp0=shm3+LDS_K+hi*1024+r32*16; const lds_cptr vp0=shm3+LDS_V+((lane>>4)&1)*32+(lane&3)*8+(4*hi+((lane&15)>>2))*64;
  const int NT=(q0+QB)/KVBLK;
  DMA_K(0,0);DMA_V(0,0);DMA_K(1,SLOTB);
  bf16x8 qr[4];
  #pragma unroll
  for(int d0=0;d0<4;++d0)qr[d0]=*reinterpret_cast<const bf16x8*>(&Qw[(long)r32*PQ+d0*16+hi*8]);
  float mhat=0.f,l_reg=0.f;f32x16 o[2];o[0]=f32x16{};o[1]=f32x16{};f32x16 negm=f32x16{};asm volatile("":"+v"(negm));
  const int qrel=wid*QBLK+r32;
  #define CMASK(P0,P1,t) do{int jb_=(t)-(NT-4); if(jb_>=0)cmask(P0,P1,jb_,qrel,hi);}while(0)
  bool resc=false;
  #define START(P0,P1) do{ const float rm=rowmax(P0,P1); resc=false; \
    { const float dl=rm; mhat=fadd_s(mhat,dl); \
      _Pragma("unroll") for(int r=0;r<16;++r){P0[r]=fsub_s(P0[r],dl);P1[r]=fsub_s(P1[r],dl);} \
      _Pragma("unroll") for(int r=0;r<16;++r)negm[r]=-mhat; asm volatile("":"+v"(negm)); } \
    _Pragma("unroll") for(int r=0;r<16;++r)P0[r]=__builtin_amdgcn_exp2f(P0[r]); }while(0)
  #define RESC() do{ if(resc){ asm volatile("s_waitcnt lgkmcnt(0)":::"memory"); \
      _Pragma("unroll") for(int d_=0;d_<2;++d_) _Pragma("unroll") for(int r=0;r<16;++r)o[d_][r]*=wsf[crow(r,hi)]; } }while(0)
  f32x16 pA0,pA1,pB0,pB1;
  int sl_prev=0,sl_cur=0,sl_next=SLOTB;
  #define ROT() do{sl_prev=sl_cur;sl_cur=sl_next;sl_next=(sl_next==(NSLOT-1)*SLOTB)?0:sl_next+SLOTB;}while(0)
  DMA_K(2,2*SLOTB);
  WAIT_BAR(3);
  qkt(pA0,pA1,Kbase,qr,negm,r32,hi);asm volatile("s_nop 15\n\ts_nop 7":"+v"(pA0),"+v"(pA1));CMASK(pA0,pA1,0);
  START(pA0,pA1);
  _Pragma("unroll") for(int r=0;r<16;++r)pA1[r]=__builtin_amdgcn_exp2f(pA1[r]);
  WAIT_BAR(0);
  DMA_K(3,0);DMA_V(1,SLOTB);
  ROT();
  kload8(kf,kp0+sl_cur);
  WAIT_BAR(2);
  s16x4 vlo[8],vhi[8]; u32x4 pw0,pw1,pw2,pw3;
  #define PKW(P,B) cvtpk_s(P[B],P[B+1])
  #define PAF(k) __builtin_bit_cast(bf16x8,pw##k)
  #define VFR(i) (bf16x8){vlo[i][0],vlo[i][1],vlo[i][2],vlo[i][3],vhi[i][0],vhi[i][1],vhi[i][2],vhi[i][3]}
  #define PIN(x) asm volatile("":"+v"(x))
  #define MX3(a,b,c) __builtin_fmaxf(__builtin_fmaxf((a),(b)),(c))
  #define GAPA(MF,A0,A1,A2,A3,W0,W1,PW) do{ MF; sacc+=A0; sacc+=A1; sacc+=A2; sacc+=A3; PIN(sacc); W0; W1; PIN(PW); SBAR(); }while(0)
  #define EX(v) __builtin_amdgcn_exp2f(v)
  #define GAPB(MF,X,B) do{ MF; X[B]=EX(X[B]); X[B+1]=EX(X[B+1]); X[B+2]=EX(X[B+2]); X[B+3]=EX(X[B+3]); PIN(X); SBAR(); }while(0)
  #define VRD(i) do{ vlo[i]=vtr(vp_+(((i)>>2)*4096+((i)&3)*1024)); vhi[i]=vtr(vp_+(((i)>>2)*4096+((i)&3)*1024+512)); }while(0)
  #define KRD(G,j) do{ if(G){ kload2(kf,kp0+sl_next,j); SBAR(); } }while(0)
  #define STEP(C0,C1,P0,P1,t,GK,GV,GL) do{ SBAR(); \
    const lds_cptr vp_=vp0+sl_prev; \
    VRD(0); SBAR(); float sacc=(P0[0]+P0[1]); \
    GAPA(C0=__builtin_amdgcn_mfma_f32_32x32x16_bf16(kf[0],qr[0],negm,0,0,0), P0[2],P0[3],P0[4],P0[5],     pw0[0]=PKW(P0,0), pw0[1]=PKW(P0,2), pw0); \
    VRD(4); SBAR(); GAPA(C1=__builtin_amdgcn_mfma_f32_32x32x16_bf16(kf[1],qr[0],negm,0,0,0), P0[6],P0[7],P0[8],P0[9],     pw0[2]=PKW(P0,4), pw0[3]=PKW(P0,6), pw0); \
    VRD(1); SBAR(); GAPA(C0=__builtin_amdgcn_mfma_f32_32x32x16_bf16(kf[2],qr[1],C0,0,0,0),   P0[10],P0[11],P0[12],P0[13], pw1[0]=PKW(P0,8), pw1[1]=PKW(P0,10), pw1); \
    VRD(5); SBAR(); GAPA(C1=__builtin_amdgcn_mfma_f32_32x32x16_bf16(kf[3],qr[1],C1,0,0,0),   P0[14],P0[15],P1[0],P1[1],   pw1[2]=PKW(P0,12),pw1[3]=PKW(P0,14), pw1); \
    VRD(2); SBAR(); GAPA(C0=__builtin_amdgcn_mfma_f32_32x32x16_bf16(kf[4],qr[2],C0,0,0,0),   P1[2],P1[3],P1[4],P1[5],     pw2[0]=PKW(P1,0), pw2[1]=PKW(P1,2), pw2); \
    VRD(6); SBAR(); GAPA(C1=__builtin_amdgcn_mfma_f32_32x32x16_bf16(kf[5],qr[2],C1,0,0,0),   P1[6],P1[7],P1[8],P1[9],     pw2[2]=PKW(P1,4), pw2[3]=PKW(P1,6), pw2); \
    VRD(3); SBAR(); GAPA(C0=__builtin_amdgcn_mfma_f32_32x32x16_bf16(kf[6],qr[3],C0,0,0,0),   P1[10],P1[11],P1[12],P1[13], pw3[0]=PKW(P1,8), pw3[1]=PKW(P1,10), pw3); \
    VRD(7); SBAR(); GAPA(C1=__builtin_amdgcn_mfma_f32_32x32x16_bf16(kf[7],qr[3],C1,0,0,0),   P1[14],P1[15],0.f,0.f,       pw3[2]=PKW(P1,12),pw3[3]=PKW(P1,14), pw3); \
    l_reg+=sacc; \
    if(GK){DMA_K((t)+3,sl_cur);} if(GV){DMA_V((t)+1,sl_next);} \
    CMASK(C0,C1,t); \
    { float a=MX3(C0[0],C0[1],C1[0]),b=MX3(C0[2],C0[3],C1[1]); a=MX3(a,C1[2],C1[3]); \
      _Pragma("unroll") for(int r=4;r<16;r+=4){a=MX3(a,C0[r],C0[r+1]);b=MX3(b,C0[r+2],C0[r+3]);a=MX3(a,C1[r],C1[r+1]);b=MX3(b,C1[r+2],C1[r+3]);} \
      float rm=__builtin_fmaxf(a,b); { auto rr=__builtin_amdgcn_permlane32_swap(__float_as_uint(rm),__float_as_uint(rm),false,false); rm=__builtin_fmaxf(__uint_as_float(rr[0]),__uint_as_float(rr[1])); } \
      resc=false; \
      if(__builtin_expect(__any(rm>(float)THRL),0)){ const float dl=__builtin_fmaxf(rm,0.f); mhat+=dl; \
        _Pragma("unroll") for(int r=0;r<16;++r){C0[r]-=dl;C1[r]-=dl;} \
        _Pragma("unroll") for(int r=0;r<16;++r)negm[r]=-mhat; asm volatile("":"+v"(negm)); \
        const float f=__builtin_amdgcn_exp2f(-dl); l_reg*=f; if(hi==0)wsf[r32]=f; resc=true; } } \
    SBAR(); \
    GAPB(o[0]=__builtin_amdgcn_mfma_f32_32x32x16_bf16(PAF(0),VFR(0),o[0],0,0,0), C0,0); \
    GAPB(o[1]=__builtin_amdgcn_mfma_f32_32x32x16_bf16(PAF(0),VFR(4),o[1],0,0,0), C0,4); \
    KRD(GL,0); GAPB(o[0]=__builtin_amdgcn_mfma_f32_32x32x16_bf16(PAF(1),VFR(1),o[0],0,0,0), C0,8); \
    KRD(GL,1); GAPB(o[1]=__builtin_amdgcn_mfma_f32_32x32x16_bf16(PAF(1),VFR(5),o[1],0,0,0), C0,12); \
    KRD(GL,2); GAPB(o[0]=__builtin_amdgcn_mfma_f32_32x32x16_bf16(PAF(2),VFR(2),o[0],0,0,0), C1,0); \
    KRD(GL,3); GAPB(o[1]=__builtin_amdgcn_mfma_f32_32x32x16_bf16(PAF(2),VFR(6),o[1],0,0,0), C1,4); \
    GAPB(o[0]=__builtin_amdgcn_mfma_f32_32x32x16_bf16(PAF(3),VFR(3),o[0],0,0,0), C1,8); \
    GAPB(o[1]=__builtin_amdgcn_mfma_f32_32x32x16_bf16(PAF(3),VFR(7),o[1],0,0,0), C1,12); \
    }while(0)
  int t=1;
  #undef CMASK
  #define CMASK(P0,P1,t) do{}while(0)
  for(;t+5<NT;t+=2){
    STEP(pB0,pB1,pA0,pA1,t,true,true,true);     WAIT_BAR(2); RESC(); ROT();
    STEP(pA0,pA1,pB0,pB1,t+1,true,true,true);   WAIT_BAR(2); RESC(); ROT();
  }
  #undef CMASK
  #define CMASK(P0,P1,t) do{int jb_=(t)-(NT-4); if(jb_>=0)cmask(P0,P1,jb_,qrel,hi);}while(0)
  #define ENDW(tt) do{ if((tt)+3<NT){WAIT_BAR(2);} else if((tt)+2<NT){WAIT_BAR(1);} else {WAIT_BAR(0);} }while(0)
  for(;t+1<NT;t+=2){
    STEP(pB0,pB1,pA0,pA1,t,(t+3<NT),(t+1<NT),(t+1<NT));       ENDW(t);   RESC(); ROT();
    STEP(pA0,pA1,pB0,pB1,t+1,(t+4<NT),(t+2<NT),(t+2<NT));     ENDW(t+1); RESC(); ROT();
  }
  STEP(pB0,pB1,pA0,pA1,NT-1,false,false,false); RESC();
  { float sacc=pB0[0]+pB0[1]; _Pragma("unroll") for(int r=2;r<16;++r)sacc+=pB0[r]; _Pragma("unroll") for(int r=0;r<16;++r)sacc+=pB1[r]; l_reg+=sacc;
    pw0=(u32x4){PKW(pB0,0),PKW(pB0,2),PKW(pB0,4),PKW(pB0,6)};pw1=(u32x4){PKW(pB0,8),PKW(pB0,10),PKW(pB0,12),PKW(pB0,14)};pw2=(u32x4){PKW(pB1,0),PKW(pB1,2),PKW(pB1,4),PKW(pB1,6)};pw3=(u32x4){PKW(pB1,8),PKW(pB1,10),PKW(pB1,12),PKW(pB1,14)};
    SBAR(); pv(o,vb0+sl_cur,PAF(0),PAF(1),PAF(2),PAF(3)); }
  #undef PKW
  #undef PAF
  #undef VFR
  #undef PIN
  #undef MX3
  #undef GAPA
  #undef GAPB
  #undef EX
  #undef VRD
  #undef KRD
  #undef STEP
  #undef ENDW
  {auto rr=__builtin_amdgcn_permlane32_swap(__float_as_uint(l_reg),__float_as_uint(l_reg),false,false);l_reg=__uint_as_float(rr[0])+__uint_as_float(rr[1]);}
  if(hi==0)wsf[32+r32]=l_reg;asm volatile("s_waitcnt lgkmcnt(0)":::"memory");
  float rli[16];
  #pragma unroll
  for(int r=0;r<16;++r)rli[r]=__builtin_amdgcn_rcpf(wsf[32+crow(r,hi)]);
  bf16*Ow=O+(long)(q0+wid*QBLK)*PO;
  { bf16*stg=(bf16*)(shm+LDS_OST)+wid*2048;
    #pragma unroll
    for(int r=0;r<16;++r){const int orow=crow(r,hi);
      #pragma unroll
      for(int d0=0;d0<2;++d0)stg[orow*64+d0*32+r32]=__float2bfloat16(o[d0][r]*rli[r]);}
    asm volatile("s_waitcnt lgkmcnt(0)":::"memory");
    #pragma unroll
    for(int i=0;i<4;++i){const int row=i*8+(lane>>3),ch=lane&7; const u32x4 v=*(const u32x4*)(stg+row*64+ch*8); ATTN_STORE16(Ow+(long)row*PO+ch*8,v);} }
  asm volatile("s_waitcnt lgkmcnt(0)\n\ts_barrier":::"memory");
  #undef DMA_K
  #undef DMA_V
  #undef CMASK
  #undef START
  #undef RESC
  #undef ROT
}
constexpr int ATTN_LDS_BYTES=LDS_BYTES;
#undef SBAR
#undef WAIT_BAR
}

constexpr int NWAVES = 8;
#ifndef MK_N_LAUNCHES
#define MK_N_LAUNCHES 1
#endif
constexpr int N_LAUNCHES = MK_N_LAUNCHES;
constexpr int PER_PHASE = 6;

constexpr int D_MODEL = 1024, BATCH = 8, SEQ = 2048, MP = BATCH * SEQ, DEC_B = 128, MTOK = MP + DEC_B, MROWS = 16640;
constexpr int D_IN = 8200, NZ = 8192, D_MIX = 2048, N_MEM = 256, NPAGES = 16, PAGE = 128;
constexpr float EPS = 1e-5f, ALPHA = 1.189207115002721f, LAM_INIT = 0.2f, LOG2E = 1.4426950408889634f;
constexpr float C2Q = 0.125f * 1.4426950408889634f;
constexpr float CQ_SCALE = 0.08838834764831845f * 1.4426950408889634f;

constexpr size_t O_YP = 0, O_YS = O_YP + (size_t)MP * 1024, O_CP = O_YS + (size_t)DEC_B * 1024, O_NP = O_CP + (size_t)BATCH * 4 * 65536, O_MPR = O_NP + BATCH * 4 * 256,
                 O_KP = O_MPR + BATCH * 4, O_VP = O_KP + (size_t)MP * 512, O_MKP = O_VP + (size_t)MP * 512, O_MVP = O_MKP + (size_t)BATCH * 256 * 512,
                 O_CS = O_MVP + (size_t)BATCH * 256 * 512, O_NS = O_CS + (size_t)DEC_B * 4 * 65536, O_MS = O_NS + (size_t)DEC_B * 4 * 256, O_KS = O_MS + DEC_B * 4,
                 O_VS = O_KS + (size_t)DEC_B * 512, O_END = O_VS + (size_t)DEC_B * 512;

constexpr size_t MiB = 1u << 20;
constexpr size_t WS_CTL = 0, CTL_ZERO_BYTES = 1 * MiB;
constexpr size_t WS_WINT = 2 * MiB;
constexpr size_t WS_WOUTT = 18 * MiB;
constexpr size_t WS_WMEMT = 22 * MiB;
constexpr size_t WS_ROPE = 24 * MiB;
constexpr size_t WS_GATES = 25 * MiB;
constexpr size_t WS_MEMB = 26 * MiB;
constexpr size_t WS_MKB = 30 * MiB;
constexpr size_t WS_MVT = 32 * MiB;
constexpr size_t WS_XB = 36 * MiB;
constexpr size_t SZ_R1024 = (size_t)MROWS * 1024 * 2;
constexpr size_t WS_QM = 72 * MiB;
constexpr size_t WS_DQ = WS_QM + 4 * SZ_R1024;
constexpr size_t SZ_R512 = (size_t)MROWS * 512 * 2;
constexpr size_t WS_SG = WS_DQ + 4 * SZ_R512;
constexpr size_t WS_HM = WS_SG + (size_t)MROWS * 2048 * 2;
constexpr size_t WS_OD = WS_HM + (size_t)MP * 1024 * 4;
constexpr size_t WS_H = WS_OD + (size_t)MP * 1024 * 2;
constexpr size_t WS_Y = WS_H + (size_t)MROWS * 2048 * 2;
constexpr size_t WS_PART = WS_Y + (size_t)MROWS * 1024 * 4;
constexpr size_t WS_END = WS_PART + (size_t)DEC_B * NPAGES * 8 * 136 * 4;
static_assert(WS_XB + SZ_R1024 <= WS_QM && WS_END < 1024 * MiB, "ws map");
static_assert(WS_QM % 256 == 0 && WS_DQ % 256 == 0 && WS_SG % 256 == 0 && WS_HM % 256 == 0 && WS_OD % 256 == 0 && WS_H % 256 == 0 && WS_Y % 256 == 0 && WS_PART % 256 == 0, "ws align");
constexpr int CW_TMO = 0, CW_CODE = 1;
constexpr int CW_BAR = 4096;

constexpr int RING_OFF = 0, RING_BYTES = 131072;
constexpr int ML_TAB = 131072;
constexpr int LDSCTL_OFF = ML_TAB + 24576, MISC_OFF = LDSCTL_OFF + 320;
constexpr int LDS_BYTES = LDSCTL_OFF + 512;
static_assert(LDS_BYTES <= 160 * 1024, "LDS");
#define GAS __attribute__((address_space(1)))
#define LAS __attribute__((address_space(3)))
typedef unsigned short bf16;
typedef unsigned v4u __attribute__((ext_vector_type(4)));
typedef float f32x4 __attribute__((ext_vector_type(4)));
typedef short bf16x8 __attribute__((ext_vector_type(8)));
typedef GAS unsigned gu32;
typedef GAS unsigned long long gu64;
#define RLX_AGENT __ATOMIC_RELAXED, __HIP_MEMORY_SCOPE_AGENT
#define LDS_WAIT() asm volatile("s_waitcnt lgkmcnt(0)" ::: "memory")
#define VM_WAIT() asm volatile("s_waitcnt vmcnt(0)" ::: "memory")
__device__ __forceinline__ unsigned long long rt() { return __builtin_amdgcn_s_memrealtime(); }
__device__ __forceinline__ unsigned f2bf(float f) { unsigned u = __builtin_bit_cast(unsigned, f); return (u + 0x7fffu + ((u >> 16) & 1u)) >> 16; }
__device__ __forceinline__ unsigned pk2(float lo, float hi) { return f2bf(lo) | (f2bf(hi) << 16); }

#define XB_TMO      128
#define XB_XCNT(j)  (256  + 64 * (j))
#define XB_XSUB(j)  (1280 + 64 * (j))
#define XB_XGEN(j)  (2304 + 64 * (j))
#define XB_TOP      3328
#define XB_TOPGEN   3392
#define XCD_BAR_WORDS 3456
#define XB_SPIN_CAP (1u << 18)

__device__ __forceinline__ unsigned xb_ld(unsigned* p)              { return __hip_atomic_load(p, __ATOMIC_RELAXED, __HIP_MEMORY_SCOPE_AGENT); }
__device__ __forceinline__ unsigned xb_add(unsigned* p, unsigned v) { return __hip_atomic_fetch_add(p, v, __ATOMIC_RELAXED, __HIP_MEMORY_SCOPE_AGENT); }
__device__ __forceinline__ unsigned xb_xcc_id() { return (unsigned)__builtin_amdgcn_s_getreg((3 << 11) | 20) & 0xFu; }
#define XB_SPIN(cond, bar) do { unsigned _sp = 0; while (cond) { __builtin_amdgcn_s_sleep(1); \
    if ((++_sp & 255u) == 0u) { if (xb_ld(&(bar)[XB_TMO])) break; if (_sp > XB_SPIN_CAP) { atomicAdd(&(bar)[XB_TMO], 1u); break; } } } } while (0)

struct XcdBarrier {
    unsigned* bar; unsigned x;
    volatile LAS unsigned* st;
};

__device__ __forceinline__ XcdBarrier xcd_barrier_post(unsigned* bar, volatile LAS unsigned* st) {
    XcdBarrier b; b.bar = bar; b.x = xb_xcc_id(); b.st = st;
    if (threadIdx.x == 0) (void)xb_add(&bar[XB_XCNT(b.x)], 1u);
    return b;
}
__device__ __forceinline__ void xcd_barrier_complete(unsigned* bar, unsigned x, unsigned& nloc, unsigned& nx) {
    const unsigned G = gridDim.x * gridDim.y * gridDim.z;
    unsigned sum, cnt, mine, sp = 0u;
    for (;;) {
        sum = 0u; cnt = 0u; mine = 0u;
#pragma unroll
        for (unsigned j = 0; j < 16; ++j) { const unsigned c = xb_ld(&bar[XB_XCNT(j)]); sum += c; cnt += (c > 0u) ? 1u : 0u; mine = (j == x) ? c : mine; }
        if (sum == G) break;
        __builtin_amdgcn_s_sleep(1);
        if ((++sp & 255u) == 0u) { if (xb_ld(&bar[XB_TMO])) break; if (sp > XB_SPIN_CAP) { atomicAdd(&bar[XB_TMO], 1u); break; } }
    }
    nloc = mine > 0u ? mine : 1u; nx = cnt > 0u ? cnt : 1u;
}

__device__ __forceinline__ void xcd_barrier(const XcdBarrier& b) {
    asm volatile("s_waitcnt vmcnt(0)" ::: "memory");
    __syncthreads();
    if (threadIdx.x == 0) {
        unsigned* bar = b.bar;
        __builtin_amdgcn_s_waitcnt(0);
        unsigned nloc = b.st[0], nx = b.st[1];
        if (nloc == 0u) { xcd_barrier_complete(bar, b.x, nloc, nx); b.st[0] = nloc; b.st[1] = nx; }
        const unsigned old = xb_add(&bar[XB_XSUB(b.x)], 1u);
        const unsigned gen = old / nloc;
        if (old + 1u == (gen + 1u) * nloc) {
            __builtin_amdgcn_fence(__ATOMIC_RELEASE, "agent");
            asm volatile("s_waitcnt vmcnt(0)" ::: "memory");
            const unsigned og = xb_add(&bar[XB_TOP], 1u);
            const unsigned tg = og / nx;
            if (og + 1u == (tg + 1u) * nx) xb_add(&bar[XB_TOPGEN], 1u);
            else XB_SPIN(xb_ld(&bar[XB_TOPGEN]) == tg, bar);
            __builtin_amdgcn_fence(__ATOMIC_ACQUIRE, "agent");
            xb_add(&bar[XB_XGEN(b.x)], 1u);
            asm volatile("s_waitcnt vmcnt(0)" ::: "memory");
        } else {
            XB_SPIN(xb_ld(&bar[XB_XGEN(b.x)]) == gen, bar);
            __builtin_amdgcn_fence(__ATOMIC_ACQUIRE, "agent");
            asm volatile("s_waitcnt vmcnt(0)" ::: "memory");
        }
    }
    __syncthreads();
}

typedef float f32x16 __attribute__((ext_vector_type(16)));
typedef float f32x2 __attribute__((ext_vector_type(2)));
typedef unsigned v2u __attribute__((ext_vector_type(2)));
typedef short v4s __attribute__((ext_vector_type(4)));
struct Frame {
    LAS unsigned char* lds;
    volatile LAS unsigned* MISC;
    gu32* ctl;
    int tid, lane, wave, vcu, G;
    const float *x_prompt, *x_sample, *st_c, *st_n, *st_m, *cache_k, *cache_v, *cmem_k, *cmem_v; const int* page_table;
    const float *mem_prompt, *w_in, *b_if, *w_mnorm, *lq1, *lk1, *lq2, *lk2, *w_dnorm, *w_memkv, *w_out, *ln_g, *ln_b;
    float* out; unsigned char* ws;
};
__device__ __forceinline__ float wave_sum(float v) {
#pragma unroll
    for (int o = 1; o < 64; o <<= 1) v += __shfl_xor(v, o);
    return v;
}
__device__ __forceinline__ float wave_max(float v) {
#pragma unroll
    for (int o = 1; o < 64; o <<= 1) v = fmaxf(v, __shfl_xor(v, o));
    return v;
}
__device__ __forceinline__ float bf2f(unsigned short b) { return __builtin_bit_cast(float, (unsigned)b << 16); }
__device__ __forceinline__ float bflo(unsigned w) { return __builtin_bit_cast(float, w << 16); }
__device__ __forceinline__ float bfhi(unsigned w) { return __builtin_bit_cast(float, w & 0xffff0000u); }
__device__ __forceinline__ unsigned cvtpk(float lo, float hi) { typedef __bf16 bf16x2_t __attribute__((ext_vector_type(2))); f32x2 v = {lo, hi}; bf16x2_t b = __builtin_convertvector(v, bf16x2_t); return __builtin_bit_cast(unsigned, b); }
__device__ __forceinline__ float fexp2(float x) { return __builtin_amdgcn_exp2f(x); }
__device__ __forceinline__ float frcp(float x) { return __builtin_amdgcn_rcpf(x); }
__device__ __forceinline__ float silu_f(float x) { return x * frcp(1.f + fexp2(-x * LOG2E)); }
__device__ __forceinline__ float sigmoid_f(float x) { return frcp(1.f + fexp2(-x * LOG2E)); }
__device__ __forceinline__ float swap32(float v) { return __shfl_xor(v, 32); }
__device__ __forceinline__ float lam_value(const Frame& F) {
    const int l = F.lane;
    const float a = wave_sum(F.lq1[l] * F.lk1[l]), b = wave_sum(F.lq2[l] * F.lk2[l]);
    return expf(a) - expf(b) + LAM_INIT;
}

__host__ __device__ __forceinline__ int zsrc_col(int n) {
    if (n < 4096) return n;
    const int local = n - 4096;
    if (local < 1024) { const int sub = local >> 6, P = local & 63, g = P >> 3, e = P & 7; const int d = (e < 4) ? (4 * g + e) : (32 + 4 * g + (e - 4)); return 4104 + sub * 64 + d; }
    return n + 8;
}

__device__ __forceinline__ void p0_transpose_item(const float* W, int ldw, int K, int nblk, bf16* WT, LAS float* scr, int item, int lane, bool zmap) {
    const int kb = item / nblk, nb = item % nblk, k0 = 64 * kb, n0 = 32 * nb;
    const int n = n0 + (lane & 31), sc = zmap ? zsrc_col(n) : n;
#pragma unroll 8
    for (int i = 0; i < 32; ++i) { const int kk = 2 * i + (lane >> 5); scr[kk * 33 + (lane & 31)] = W[(size_t)(k0 + kk) * ldw + sc]; }
    LDS_WAIT(); asm volatile("" ::: "memory");
    const int c = lane & 7;
#pragma unroll
    for (int j = 0; j < 4; ++j) { const int nn = (lane >> 3) + 8 * j; const LAS float* s = scr + (8 * c) * 33 + nn;
        v4u o; o.x = pk2(s[0 * 33], s[1 * 33]); o.y = pk2(s[2 * 33], s[3 * 33]); o.z = pk2(s[4 * 33], s[5 * 33]); o.w = pk2(s[6 * 33], s[7 * 33]);
        *(GAS v4u*)(WT + (size_t)(n0 + nn) * K + k0 + 8 * c) = o; }
    LDS_WAIT(); asm volatile("" ::: "memory");
}
__device__ __forceinline__ void p0_prologue(Frame& F) {
    const int gw = F.vcu * NWAVES + F.wave, NGW = F.G * NWAVES;
    LAS float* gwl = (LAS float*)(F.lds + 98304);
    for (int i = F.tid; i < 8192; i += NWAVES * 64) gwl[i] = F.w_in[(size_t)(i >> 3) * D_IN + 4096 + (i & 7)];
    __syncthreads();
    bf16* XB = (bf16*)(F.ws + WS_XB); float* GATES = (float*)(F.ws + WS_GATES);
    for (int row = gw; row < MROWS; row += NGW) {
        const float* src = row < MP ? F.x_prompt + (size_t)row * 1024 : (row < MTOK ? F.x_sample + (size_t)(row - MP) * 1024 : nullptr);
        f32x4 v[4];
#pragma unroll
        for (int j = 0; j < 4; ++j) v[j] = src ? *((const GAS f32x4*)src + F.lane + 64 * j) : (f32x4){0.f, 0.f, 0.f, 0.f};
        GAS unsigned long long* o8 = (GAS unsigned long long*)(XB + (size_t)row * 1024) + F.lane;
#pragma unroll
        for (int j = 0; j < 4; ++j) o8[64 * j] = (unsigned long long)cvtpk(v[j].x, v[j].y) | ((unsigned long long)cvtpk(v[j].z, v[j].w) << 32);
        float g[8];
#pragma unroll
        for (int c = 0; c < 8; ++c) g[c] = 0.f;
#pragma unroll
        for (int j = 0; j < 4; ++j)
#pragma unroll
            for (int e = 0; e < 4; ++e) { const int k = 256 * j + 4 * F.lane + e; const f32x4 w0 = *(const LAS f32x4*)(gwl + k * 8), w1 = *(const LAS f32x4*)(gwl + k * 8 + 4); const float xv = v[j][e];
                g[0] += xv * w0.x; g[1] += xv * w0.y; g[2] += xv * w0.z; g[3] += xv * w0.w; g[4] += xv * w1.x; g[5] += xv * w1.y; g[6] += xv * w1.z; g[7] += xv * w1.w; }
#pragma unroll
        for (int c = 0; c < 8; ++c) g[c] = wave_sum(g[c]);
        if (F.lane < 8) {
            float val = 0.f;
#pragma unroll
            for (int c = 0; c < 8; ++c) if (F.lane == c) val = g[c];
            val += F.b_if[F.lane];
            if (F.lane >= 4) val = fminf(val, 0.f) - log1pf(expf(-fabsf(val)));
            GATES[(size_t)row * 8 + F.lane] = val;
        }
    }
    { bf16* MB = (bf16*)(F.ws + WS_MEMB);
      for (int row = gw; row < BATCH * N_MEM; row += NGW) {
        const GAS f32x4* xr = (const GAS f32x4*)(F.mem_prompt + (size_t)row * 1024) + F.lane;
        GAS unsigned long long* o8 = (GAS unsigned long long*)(MB + (size_t)row * 1024) + F.lane;
#pragma unroll
        for (int j = 0; j < 4; ++j) { const f32x4 v = xr[64 * j]; o8[64 * j] = (unsigned long long)cvtpk(v.x, v.y) | ((unsigned long long)cvtpk(v.z, v.w) << 32); } } }
    { float* RT = (float*)(F.ws + WS_ROPE);
      for (int i = (F.vcu * NWAVES * 64) + F.tid; i < 2049 * 32; i += F.G * NWAVES * 64) {
        const int pos = i >> 5, d = i & 31;
        const float inv = powf(10000.0f, -(float)d / 32.0f); const float ang = (float)pos * inv;
        const double a = (double)ang; const double kk = rint(a * 0.15915494309189535); const float r = (float)(a - kk * 6.283185307179586);
        RT[2 * i] = cosf(r); RT[2 * i + 1] = sinf(r); } }
    LAS float* scr = (LAS float*)(F.lds + RING_OFF + F.wave * 8448);
    constexpr int I_IN = (1024 / 64) * (NZ / 32), I_OUT = (2048 / 64) * (1024 / 32), I_MEM = (1024 / 64) * (1024 / 32);
    for (int it = gw; it < I_IN + I_OUT + I_MEM; it += NGW) {
        int r = it;
        if (r < I_IN) { p0_transpose_item(F.w_in, D_IN, 1024, NZ / 32, (bf16*)(F.ws + WS_WINT), scr, r, F.lane, true); continue; } r -= I_IN;
        if (r < I_OUT) { p0_transpose_item(F.w_out, 1024, 2048, 1024 / 32, (bf16*)(F.ws + WS_WOUTT), scr, r, F.lane, false); continue; } r -= I_OUT;
        p0_transpose_item(F.w_memkv, 1024, 1024, 1024 / 32, (bf16*)(F.ws + WS_WMEMT), scr, r, F.lane, false);
    }
}

namespace pg8 {
__device__ __forceinline__ u32x4 pack8(const f32x4& a, const f32x4& b) { u32x4 w; w.x = cvt_pk_bf16(a[0], a[1]); w.y = cvt_pk_bf16(a[2], a[3]); w.z = cvt_pk_bf16(b[0], b[1]); w.w = cvt_pk_bf16(b[2], b[3]); return w; }
typedef unsigned u32x2 __attribute__((ext_vector_type(2)));
struct EpiZ {
    static constexpr bool PERM = true, AFTER_DRAIN = false;
    unsigned char* ws; float* out;
    __device__ __forceinline__ void operator()(const f32x4 (&acc)[2][2][4][2], const Unit& u, int wr, int wc, int fr, int fq) const {
        const int pn = u.pn, rbase = u.pm * BM + wr * 64 + fr, cl0 = wc * 32 + 8 * fq;
        if (pn < 16) {
            const int t = pn >> 2; bf16_t* dst = (bf16_t*)(ws + WS_QM + (size_t)t * SZ_R1024); const float sc = (t == 1) ? 0.0625f : 1.f;
#pragma unroll
            for (int ai = 0; ai < 2; ++ai)
#pragma unroll
                for (int m = 0; m < 4; ++m) { const int row = rbase + ai * HALF + m * 16;
#pragma unroll
                    for (int bj = 0; bj < 2; ++bj) { const int col = (pn & 3) * 256 + bj * HALF + cl0;
                        *(u32x4*)(dst + (size_t)row * 1024 + col) = pack8(acc[ai][bj][m][0] * sc, acc[ai][bj][m][1] * sc); } }
        } else if (pn < 20) {
            const bool isk = pn >= 18; const int cbase = (pn & 1) * 256;
            bf16_t* dst = (bf16_t*)(ws + WS_DQ + (isk ? SZ_R512 : 0)); const float* rope = (const float*)(ws + WS_ROPE);
#pragma unroll
            for (int ai = 0; ai < 2; ++ai)
#pragma unroll
                for (int m = 0; m < 4; ++m) { const int row = rbase + ai * HALF + m * 16; const int pos = row < MP ? (row & (SEQ - 1)) : SEQ;
#pragma unroll
                    for (int bj = 0; bj < 2; ++bj) { const int cq = cbase + bj * HALF + cl0, sub = cq >> 6, g = (cq & 63) >> 3;
                        const float* rp = rope + ((size_t)pos * 32 + 4 * g) * 2; const f32x4 r0 = *(const f32x4*)rp, r1 = *(const f32x4*)(rp + 4);
                        const f32x4 t1 = acc[ai][bj][m][0], t2 = acc[ai][bj][m][1]; f32x4 o1, o2;
                        o1[0] = t1[0] * r0[0] - t2[0] * r0[1]; o2[0] = t2[0] * r0[0] + t1[0] * r0[1];
                        o1[1] = t1[1] * r0[2] - t2[1] * r0[3]; o2[1] = t2[1] * r0[2] + t1[1] * r0[3];
                        o1[2] = t1[2] * r1[0] - t2[2] * r1[1]; o2[2] = t2[2] * r1[0] + t1[2] * r1[1];
                        o1[3] = t1[3] * r1[2] - t2[3] * r1[3]; o2[3] = t2[3] * r1[2] + t1[3] * r1[3];
                        const int c1 = sub * 64 + 4 * g, c2 = c1 + 32;
                        if (!isk) { o1 = o1 * C2Q; o2 = o2 * C2Q; }
                        else if (row < MTOK) { float* fo = row < MP ? out + O_KP + (size_t)row * 512 : out + O_KS + (size_t)(row - MP) * 512; *(f32x4*)(fo + c1) = o1; *(f32x4*)(fo + c2) = o2; }
                        u32x2 w1, w2; w1.x = cvt_pk_bf16(o1[0], o1[1]); w1.y = cvt_pk_bf16(o1[2], o1[3]); w2.x = cvt_pk_bf16(o2[0], o2[1]); w2.y = cvt_pk_bf16(o2[2], o2[3]);
                        *(u32x2*)(dst + (size_t)row * 512 + c1) = w1; *(u32x2*)(dst + (size_t)row * 512 + c2) = w2; } }
        } else if (pn < 24) {
            const bool isv = pn < 22; const int cbase = (pn & 1) * 256;
            bf16_t* dst = (bf16_t*)(ws + WS_DQ + (isv ? 2 : 3) * SZ_R512); const float sc = isv ? 1.f : CQ_SCALE;
#pragma unroll
            for (int ai = 0; ai < 2; ++ai)
#pragma unroll
                for (int m = 0; m < 4; ++m) { const int row = rbase + ai * HALF + m * 16;
#pragma unroll
                    for (int bj = 0; bj < 2; ++bj) { const int col = cbase + bj * HALF + cl0; const f32x4 a = acc[ai][bj][m][0], b = acc[ai][bj][m][1];
                        if (isv && row < MTOK) { float* fo = (row < MP ? out + O_VP + (size_t)row * 512 : out + O_VS + (size_t)(row - MP) * 512) + col; *(f32x4*)fo = a; *(f32x4*)(fo + 4) = b; }
                        *(u32x4*)(dst + (size_t)row * 512 + col) = pack8(a * sc, b * sc); } }
        } else {
            bf16_t* dst = (bf16_t*)(ws + WS_SG);
#pragma unroll
            for (int ai = 0; ai < 2; ++ai)
#pragma unroll
                for (int m = 0; m < 4; ++m) { const int row = rbase + ai * HALF + m * 16;
#pragma unroll
                    for (int bj = 0; bj < 2; ++bj) { const int col = (pn - 24) * 256 + bj * HALF + cl0; f32x4 a = acc[ai][bj][m][0], b = acc[ai][bj][m][1];
#pragma unroll
                        for (int e = 0; e < 4; ++e) { a[e] = silu_f(a[e]); b[e] = silu_f(b[e]); }
                        *(u32x4*)(dst + (size_t)row * 2048 + col) = pack8(a, b); } }
        }
    }
};
struct EpiMem {
    static constexpr bool PERM = true, AFTER_DRAIN = false;
    unsigned char* ws; float* out;
    __device__ __forceinline__ void operator()(const f32x4 (&acc)[2][2][4][2], const Unit& u, int wr, int wc, int fr, int fq) const {
        const int pn = u.pn, rbase = u.pm * BM + wr * 64 + fr, cl0 = wc * 32 + 8 * fq; const bool isv = pn >= 2;
        float* fo = out + (isv ? O_MVP : O_MKP); bf16_t* mkb = (bf16_t*)(ws + WS_MKB); bf16_t* mvt = (bf16_t*)(ws + WS_MVT);
#pragma unroll
        for (int ai = 0; ai < 2; ++ai)
#pragma unroll
            for (int m = 0; m < 4; ++m) { const int row = rbase + ai * HALF + m * 16;
#pragma unroll
                for (int bj = 0; bj < 2; ++bj) { const int col = (pn & 1) * 256 + bj * HALF + cl0; const f32x4 a = acc[ai][bj][m][0], b = acc[ai][bj][m][1];
                    *(f32x4*)(fo + (size_t)row * 512 + col) = a; *(f32x4*)(fo + (size_t)row * 512 + col + 4) = b;
                    if (!isv) *(u32x4*)(mkb + (size_t)row * 512 + col) = pack8(a, b);
                    else { const int bb = row >> 8, key = row & 255, hh = col >> 7, d = col & 127; bf16_t* tp = mvt + ((size_t)((bb * 4 + hh) * 128 + d)) * 256 + key;
                        const u32x4 w = pack8(a, b);
                        tp[0 * 256] = (bf16_t)(w.x & 0xffff); tp[1 * 256] = (bf16_t)(w.x >> 16); tp[2 * 256] = (bf16_t)(w.y & 0xffff); tp[3 * 256] = (bf16_t)(w.y >> 16);
                        tp[4 * 256] = (bf16_t)(w.z & 0xffff); tp[5 * 256] = (bf16_t)(w.z >> 16); tp[6 * 256] = (bf16_t)(w.w & 0xffff); tp[7 * 256] = (bf16_t)(w.w >> 16); } } }
    }
};
struct EpiOut {
    static constexpr bool PERM = false, AFTER_DRAIN = false;
    const float* xp; const float* xs; float* Y;
    __device__ __forceinline__ void operator()(const f32x4 (&acc)[2][2][4][2], const Unit& u, int wr, int wc, int fr, int fq) const {
        const int row0 = u.pm * BM + wr * 64 + fr, col0 = u.pn * BM + wc * 32 + 4 * fq;
#pragma unroll
        for (int ai = 0; ai < 2; ++ai)
#pragma unroll
            for (int m = 0; m < 4; ++m) { const int row = row0 + ai * HALF + m * 16; float* rowp = Y + (size_t)row * 1024 + col0;
                const float* xr = row < MP ? xp + (size_t)row * 1024 + col0 : (row < MTOK ? xs + (size_t)(row - MP) * 1024 + col0 : nullptr);
#pragma unroll
                for (int bj = 0; bj < 2; ++bj)
#pragma unroll
                    for (int n = 0; n < 2; ++n) { f32x4 xv = xr ? *(const f32x4*)(xr + bj * HALF + n * 16) : (f32x4){0.f, 0.f, 0.f, 0.f}; *(f32x4*)(rowp + bj * HALF + n * 16) = acc[ai][bj][m][n] + xv * ALPHA; } }
    }
};
}

constexpr int ML_KC = 0, ML_KSTR = 264, ML_VS = 67584, ML_VSTR = 40, ML_VWS = 77824, ML_CS = 88064, ML_RED = 108544, ML_NV = 125952, ML_CH = 126976;
typedef __attribute__((address_space(3))) v4s* lds_v4s_ptr;
__device__ __forceinline__ v4s tr16(LAS const unsigned char* p) { return __builtin_bit_cast(v4s, __builtin_amdgcn_ds_read_tr16_b64_v4i16((lds_v4s_ptr)p)); }
__device__ __forceinline__ bf16x8 cat8(v4s a, v4s b) { return (bf16x8){a[0], a[1], a[2], a[3], b[0], b[1], b[2], b[3]}; }
__device__ __forceinline__ void p2_mlstm(Frame& F) {
    const int v = F.vcu, bh = v >> 3, jsl = v & 7, b = bh >> 2, h = bh & 3;
    const int tid = F.tid, lane = F.lane, w = F.wave, r32 = lane & 31, hi = lane >> 5, q4 = (lane & 15) >> 2, p4 = lane & 3, blk = (lane >> 4) & 1;
    LAS unsigned char* L = F.lds;
    LAS float* TG = (LAS float*)(L + ML_TAB); LAS float* TMX = TG + 2048; LAS float* TMT = TMX + 2048;
    LAS float* NV = (LAS float*)(L + ML_NV); LAS float* CH = (LAS float*)(L + ML_CH);
    const float* GATES = (const float*)(F.ws + WS_GATES);
    const bf16* QM = (const bf16*)(F.ws + WS_QM); const bf16* KM = (const bf16*)(F.ws + WS_QM + SZ_R1024); const bf16* VM = (const bf16*)(F.ws + WS_QM + 2 * SZ_R1024);
    float* HM = (float*)(F.ws + WS_HM);
    const size_t rowbase = (size_t)b * SEQ;
#pragma unroll
    for (int cc = 0; cc < 2; ++cc) {
        const int c = 2 * w + cc, t0 = 128 * c + 2 * lane;
        const float ig0 = GATES[(rowbase + t0) * 8 + h], ig1 = GATES[(rowbase + t0 + 1) * 8 + h], lf0 = GATES[(rowbase + t0) * 8 + 4 + h], lf1 = GATES[(rowbase + t0 + 1) * 8 + 4 + h];
        float incl = lf0 + lf1;
#pragma unroll
        for (int o = 1; o < 64; o <<= 1) { const float t = __shfl_up(incl, o); if (lane >= o) incl += t; }
        const float bc1 = incl, bc0 = incl - lf1;
        const float g0 = ig0 - bc0, g1 = ig1 - bc1;
        float pm = fmaxf(g0, g1);
#pragma unroll
        for (int o = 1; o < 64; o <<= 1) { const float t = __shfl_up(pm, o); if (lane >= o) pm = fmaxf(pm, t); }
        float pe = __shfl_up(pm, 1); if (lane == 0) pe = -INFINITY;
        const float a0 = fmaxf(pe, g0), a1 = fmaxf(a0, g1);
        TG[t0] = g0; TG[t0 + 1] = g1; TMX[t0] = a0; TMX[t0 + 1] = a1; TMT[t0] = bc0; TMT[t0 + 1] = bc1;
        if (lane == 63) { CH[c] = a1; CH[16 + c] = bc1; }
    }
    for (int i = tid; i < 256; i += NWAVES * 64) NV[i] = 0.f;
    __syncthreads();
    if (tid == 0) { float m = 0.f; CH[32] = 0.f; for (int c = 0; c < 16; ++c) { m = CH[16 + c] + fmaxf(CH[c], m); CH[33 + c] = m; } }
    __syncthreads();
    for (int t = tid; t < 2048; t += NWAVES * 64) { const float mk = CH[32 + (t >> 7)]; const float mx = fmaxf(TMX[t], mk); TMX[t] = mx; TMT[t] += mx; }
    __syncthreads();
    const int tb = w & 3, kh = w >> 2;
    f32x16 accC;
#pragma unroll
    for (int i = 0; i < 16; ++i) accC[i] = 0.f;
    for (int k = 0; k < 16; ++k) {
        const size_t crow = rowbase + 128 * k;
        const float m_k = CH[32 + k], m_k1 = CH[33 + k], B_k = CH[16 + k];
        bf16x8 qf[16];
        { const bf16* qp = QM + (crow + 32 * tb + r32) * 1024 + h * 256 + 8 * hi;
#pragma unroll
          for (int ks = 0; ks < 16; ++ks) qf[ks] = *(const GAS bf16x8*)(qp + 16 * ks); }
        { const int c16 = tid & 31, r0 = tid >> 5;
          v4u kr[8];
#pragma unroll
          for (int r = 0; r < 8; ++r) kr[r] = *(const GAS v4u*)(KM + (crow + r0 + 16 * r) * 1024 + h * 256 + 8 * c16);
          const int vrow = tid >> 2, vch = tid & 3;
          const v4u vv = *(const GAS v4u*)(VM + (crow + vrow) * 1024 + h * 256 + 32 * jsl + 8 * vch);
          const float we = fexp2((B_k + TG[128 * k + vrow] - m_k1) * LOG2E);
#pragma unroll
          for (int r = 0; r < 8; ++r) *(LAS v4u*)(L + ML_KC + ((r0 + 16 * r) * ML_KSTR + 8 * c16) * 2) = kr[r];
          *(LAS v4u*)(L + ML_VS + (vrow * ML_VSTR + 8 * vch) * 2) = vv;
          v4u vw; vw.x = cvtpk(bflo(vv.x) * we, bfhi(vv.x) * we); vw.y = cvtpk(bflo(vv.y) * we, bfhi(vv.y) * we); vw.z = cvtpk(bflo(vv.z) * we, bfhi(vv.z) * we); vw.w = cvtpk(bflo(vv.w) * we, bfhi(vv.w) * we);
          *(LAS v4u*)(L + ML_VWS + (vrow * ML_VSTR + 8 * vch) * 2) = vw; }
        __syncthreads();
        const int tl = 32 * tb + r32, tg = 128 * k + tl;
        const float mx_t = TMX[tg];
        f32x16 accY;
#pragma unroll
        for (int i = 0; i < 16; ++i) accY[i] = 0.f;
        float den = 0.f;
        if (k > 0) {
            float qn = 0.f;
#define ML_INTER(KS0) _Pragma("unroll") for (int kk = 0; kk < 8; ++kk) { const int ks = (KS0) + kk; \
                LAS const unsigned char* cp = L + ML_CS + ((16 * ks + 8 * hi + q4) * ML_VSTR + 16 * blk + 4 * p4) * 2; \
                const bf16x8 a = cat8(tr16(cp), tr16(cp + 4 * ML_VSTR * 2)); \
                accY = __builtin_amdgcn_mfma_f32_32x32x16_bf16(a, qf[ks], accY, 0, 0, 0); \
                const f32x4 n0 = *(const LAS f32x4*)(NV + 16 * ks + 8 * hi), n1 = *(const LAS f32x4*)(NV + 16 * ks + 8 * hi + 4); \
                const bf16x8 qq = qf[ks]; \
                qn += bf2f((unsigned short)qq[0]) * n0[0] + bf2f((unsigned short)qq[1]) * n0[1] + bf2f((unsigned short)qq[2]) * n0[2] + bf2f((unsigned short)qq[3]) * n0[3] \
                    + bf2f((unsigned short)qq[4]) * n1[0] + bf2f((unsigned short)qq[5]) * n1[1] + bf2f((unsigned short)qq[6]) * n1[2] + bf2f((unsigned short)qq[7]) * n1[3]; }
            if (kh == 0) { ML_INTER(0) } else { ML_INTER(8) }
#undef ML_INTER
            qn += swap32(qn);
            const float winter = fexp2((m_k - mx_t) * LOG2E);
#pragma unroll
            for (int i = 0; i < 16; ++i) accY[i] *= winter;
            den = winter * qn;
        }
        float dsum = 0.f;
#pragma unroll
        for (int sbi = 0; sbi < 2; ++sbi) { const int sb = 2 * kh + sbi;
            f32x16 accS;
#pragma unroll
            for (int i = 0; i < 16; ++i) accS[i] = 0.f;
            LAS const unsigned char* kp = L + ML_KC + ((32 * sb + r32) * ML_KSTR + 8 * hi) * 2;
#pragma unroll
            for (int ks = 0; ks < 16; ++ks) { const bf16x8 a = *(const LAS bf16x8*)(kp + 32 * ks); accS = __builtin_amdgcn_mfma_f32_32x32x16_bf16(a, qf[ks], accS, 0, 0, 0); }
            float pvals[16];
#pragma unroll
            for (int i = 0; i < 16; ++i) { const int sl = 32 * sb + (i & 3) + 8 * (i >> 2) + 4 * hi;
                const float wgt = (sl <= tl) ? fexp2((TG[128 * k + sl] - mx_t) * LOG2E) : 0.f; const float pv = accS[i] * wgt; pvals[i] = pv; dsum += pv; }
#pragma unroll
            for (int sp = 0; sp < 2; ++sp) {
                v4u pw; pw.x = cvtpk(pvals[8 * sp + 0], pvals[8 * sp + 1]); pw.y = cvtpk(pvals[8 * sp + 2], pvals[8 * sp + 3]); pw.z = cvtpk(pvals[8 * sp + 4], pvals[8 * sp + 5]); pw.w = cvtpk(pvals[8 * sp + 6], pvals[8 * sp + 7]);
                LAS const unsigned char* vp = L + ML_VS + ((32 * sb + 16 * sp + 4 * hi + q4) * ML_VSTR + 16 * blk + 4 * p4) * 2;
                const bf16x8 a = cat8(tr16(vp), tr16(vp + 8 * ML_VSTR * 2));
                accY = __builtin_amdgcn_mfma_f32_32x32x16_bf16(a, __builtin_bit_cast(bf16x8, pw), accY, 0, 0, 0); } }
        dsum += swap32(dsum);
        den += dsum;
        LAS float* RED = (LAS float*)(L + ML_RED + tb * 4352);
        if (kh == 1) {
#pragma unroll
            for (int i = 0; i < 16; ++i) RED[i * 64 + lane] = accY[i];
            RED[1024 + lane] = den;
        }
        __syncthreads();
        if (kh == 0) {
#pragma unroll
            for (int i = 0; i < 16; ++i) accY[i] += RED[i * 64 + lane];
            den += RED[1024 + lane];
            const float inv = frcp(fmaxf(fabsf(den), fexp2(-TMT[tg] * LOG2E)));
            float* hp = HM + (crow + tl) * 1024 + h * 256 + 32 * jsl + 4 * hi;
#pragma unroll
            for (int g = 0; g < 4; ++g) *(GAS f32x4*)(hp + 8 * g) = (f32x4){accY[4 * g] * inv, accY[4 * g + 1] * inv, accY[4 * g + 2] * inv, accY[4 * g + 3] * inv};
        }
        const float decay = fexp2((B_k + m_k - m_k1) * LOG2E);
#pragma unroll
        for (int i = 0; i < 16; ++i) accC[i] *= decay;
#pragma unroll
        for (int ks = 0; ks < 8; ++ks) {
            LAS const unsigned char* ka = L + ML_KC + ((16 * ks + 8 * hi + q4) * ML_KSTR + 32 * w + 16 * blk + 4 * p4) * 2;
            LAS const unsigned char* vb = L + ML_VWS + ((16 * ks + 8 * hi + q4) * ML_VSTR + 16 * blk + 4 * p4) * 2;
            const bf16x8 a = cat8(tr16(ka), tr16(ka + 4 * ML_KSTR * 2)), bb = cat8(tr16(vb), tr16(vb + 4 * ML_VSTR * 2));
            accC = __builtin_amdgcn_mfma_f32_32x32x16_bf16(a, bb, accC, 0, 0, 0); }
        { LAS unsigned short* cs = (LAS unsigned short*)(L + ML_CS);
#pragma unroll
          for (int i = 0; i < 16; i += 2) { const int d = 32 * w + (i & 3) + 8 * (i >> 2) + 4 * hi; const unsigned pk = cvtpk(accC[i], accC[i + 1]);
              cs[d * ML_VSTR + r32] = (unsigned short)(pk & 0xffff); cs[(d + 1) * ML_VSTR + r32] = (unsigned short)(pk >> 16); } }
        if (tid < 256) {
            float s = 0.f; LAS const unsigned short* kc = (LAS const unsigned short*)(L + ML_KC) + tid;
#pragma unroll 8
            for (int sidx = 0; sidx < 128; ++sidx) s += fexp2((B_k + TG[128 * k + sidx] - m_k1) * LOG2E) * bf2f(kc[sidx * ML_KSTR]);
            NV[tid] = decay * NV[tid] + s;
        }
        __syncthreads();
    }
    { float* oc = F.out + O_CP + ((size_t)bh * 256) * 256 + 32 * jsl + r32;
#pragma unroll
      for (int i = 0; i < 16; ++i) { const int d = 32 * w + (i & 3) + 8 * (i >> 2) + 4 * hi; oc[(size_t)d * 256] = accC[i]; }
      if (jsl == 0) { if (tid < 256) F.out[O_NP + bh * 256 + tid] = NV[tid]; if (tid == 0) F.out[O_MPR + bh] = CH[48]; } }
    __syncthreads();
}

__device__ __forceinline__ void p2_diffattn(Frame& F, char* lds_generic) {
    const int v = F.vcu, hd = v >> 1, b = hd >> 4, rem = hd & 15, h = rem >> 2, c = (rem >> 1) & 1, jv = rem & 1;
    const attn_body::bf16* Q = (const attn_body::bf16*)(F.ws + WS_DQ) + (size_t)b * SEQ * 512 + (h * 2 + c) * 64;
    const attn_body::bf16* K = (const attn_body::bf16*)(F.ws + WS_DQ + SZ_R512) + (size_t)b * SEQ * 512 + (h * 2 + c) * 64;
    const attn_body::bf16* V = (const attn_body::bf16*)(F.ws + WS_DQ + 2 * SZ_R512) + (size_t)b * SEQ * 512 + h * 128 + jv * 64;
    attn_body::bf16* O = (attn_body::bf16*)(F.ws + WS_OD) + (size_t)b * SEQ * 1024 + (h * 2 + c) * 128 + jv * 64;
    for (int i = 0; i < 4; ++i) {
        const int qb = (v & 1) ? ((i == 0) ? 6 : (i == 1) ? 1 : (i == 2) ? 4 : 3) : ((i == 0) ? 7 : (i == 1) ? 0 : (i == 2) ? 5 : 2);
        attn_body::attn_unit<8>(qb, Q, K, V, O, lds_generic);
    }
}

__device__ __forceinline__ void p2_memattn(Frame& F) {
    const int v = F.vcu, b = v >> 5, h = (v >> 3) & 3, qblk = v & 7;
    const int lane = F.lane, w = F.wave, r32 = lane & 31, hi = lane >> 5;
    const size_t row = (size_t)b * SEQ + qblk * 256 + w * 32 + r32;
    const bf16* CQ = (const bf16*)(F.ws + WS_DQ + 3 * SZ_R512); const bf16* MKB = (const bf16*)(F.ws + WS_MKB); const bf16* MVT = (const bf16*)(F.ws + WS_MVT);
    const bf16* SG = (const bf16*)(F.ws + WS_SG); bf16* H = (bf16*)(F.ws + WS_H);
    bf16x8 qf[8];
#pragma unroll
    for (int ks = 0; ks < 8; ++ks) qf[ks] = *(const GAS bf16x8*)(CQ + row * 512 + h * 128 + 16 * ks + 8 * hi);
    f32x16 s[8];
#pragma unroll
    for (int kb = 0; kb < 8; ++kb) {
#pragma unroll
        for (int i = 0; i < 16; ++i) s[kb][i] = 0.f;
        const bf16* kp = MKB + ((size_t)b * 256 + 32 * kb + r32) * 512 + h * 128 + 8 * hi;
#pragma unroll
        for (int ks = 0; ks < 8; ++ks) { const bf16x8 a = *(const GAS bf16x8*)(kp + 16 * ks); s[kb] = __builtin_amdgcn_mfma_f32_32x32x16_bf16(a, qf[ks], s[kb], 0, 0, 0); } }
    float mx = -INFINITY;
#pragma unroll
    for (int kb = 0; kb < 8; ++kb)
#pragma unroll
        for (int i = 0; i < 16; ++i) mx = fmaxf(mx, s[kb][i]);
    mx = fmaxf(mx, swap32(mx));
    float l = 0.f;
#pragma unroll
    for (int kb = 0; kb < 8; ++kb)
#pragma unroll
        for (int i = 0; i < 16; ++i) { const float p = fexp2(s[kb][i] - mx); s[kb][i] = p; l += p; }
    l += swap32(l);
    const float inv = frcp(l);
    f32x16 o[4];
#pragma unroll
    for (int dt = 0; dt < 4; ++dt)
#pragma unroll
        for (int i = 0; i < 16; ++i) o[dt][i] = 0.f;
#pragma unroll
    for (int kb = 0; kb < 8; ++kb)
#pragma unroll
        for (int sp = 0; sp < 2; ++sp) {
            v4u pw; pw.x = cvtpk(s[kb][8 * sp + 0], s[kb][8 * sp + 1]); pw.y = cvtpk(s[kb][8 * sp + 2], s[kb][8 * sp + 3]); pw.z = cvtpk(s[kb][8 * sp + 4], s[kb][8 * sp + 5]); pw.w = cvtpk(s[kb][8 * sp + 6], s[kb][8 * sp + 7]);
            const bf16x8 pb = __builtin_bit_cast(bf16x8, pw);
#pragma unroll
            for (int dt = 0; dt < 4; ++dt) { const bf16* vp = MVT + ((size_t)((b * 4 + h) * 128 + 32 * dt + r32)) * 256 + 32 * kb + 16 * sp + 4 * hi;
                const v4s a0 = *(const GAS v4s*)vp, a1 = *(const GAS v4s*)(vp + 8);
                o[dt] = __builtin_amdgcn_mfma_f32_32x32x16_bf16(cat8(a0, a1), pb, o[dt], 0, 0, 0); } }
#pragma unroll
    for (int dt = 0; dt < 4; ++dt)
#pragma unroll
        for (int g = 0; g < 4; ++g) { const size_t off = row * 2048 + 1536 + h * 128 + 32 * dt + 8 * g + 4 * hi; const v2u sg = *(const GAS v2u*)(SG + off);
            v2u ov; ov.x = cvtpk(o[dt][4 * g] * inv * bflo(sg.x), o[dt][4 * g + 1] * inv * bfhi(sg.x)); ov.y = cvtpk(o[dt][4 * g + 2] * inv * bflo(sg.y), o[dt][4 * g + 3] * inv * bfhi(sg.y));
            *(GAS v2u*)(H + off) = ov; }
}

__device__ __forceinline__ void p2_dec_mlstm(Frame& F, int unit) {
    const int b = unit >> 2, h = unit & 3, tid = F.tid, lane = F.lane, w = F.wave;
    LAS float* Lq = (LAS float*)(F.lds); LAS float* Lk = Lq + 256; LAS float* Lv = Lk + 256; LAS float* Ln = Lv + 256; LAS float* Lsc = Ln + 256; LAS float* RED = Lsc + 64;
    const size_t drow = (size_t)MP + b;
    const bf16* QM = (const bf16*)(F.ws + WS_QM); const bf16* KM = (const bf16*)(F.ws + WS_QM + SZ_R1024); const bf16* VM = (const bf16*)(F.ws + WS_QM + 2 * SZ_R1024); const bf16* MO = (const bf16*)(F.ws + WS_QM + 3 * SZ_R1024);
    const float* GATES = (const float*)(F.ws + WS_GATES);
    if (tid < 256) { Lq[tid] = bf2f(QM[drow * 1024 + h * 256 + tid]); Lk[tid] = bf2f(KM[drow * 1024 + h * 256 + tid]); Lv[tid] = bf2f(VM[drow * 1024 + h * 256 + tid]); Ln[tid] = F.st_n[(size_t)(b * 4 + h) * 256 + tid]; }
    __syncthreads();
    if (w == 0) {
        float qk = 0.f, qn = 0.f;
#pragma unroll
        for (int e = 0; e < 4; ++e) { qk += Lq[4 * lane + e] * Lk[4 * lane + e]; qn += Lq[4 * lane + e] * Ln[4 * lane + e]; }
        qk = wave_sum(qk); qn = wave_sum(qn);
        if (lane == 0) { const float ig = GATES[drow * 8 + h], lf = GATES[drow * 8 + 4 + h], m0 = F.st_m[b * 4 + h];
            const float mt = fmaxf(ig, lf + m0), win = expf(ig - mt), winter = expf(lf + m0 - mt);
            Lsc[0] = win; Lsc[1] = winter; Lsc[2] = qk * win; Lsc[3] = qk * win + winter * qn; Lsc[4] = expf(-mt); Lsc[5] = mt; }
    }
    __syncthreads();
    const float win = Lsc[0], winter = Lsc[1];
    const float* C0 = F.st_c + (size_t)(b * 4 + h) * 65536; float* C1 = F.out + O_CS + (size_t)(b * 4 + h) * 65536;
    const f32x4 vv = *(const LAS f32x4*)(Lv + 4 * lane);
    f32x4 qc = {0.f, 0.f, 0.f, 0.f};
#pragma unroll
    for (int rr = 0; rr < 32; rr += 8) {
        f32x4 c[8];
#pragma unroll
        for (int u = 0; u < 8; ++u) c[u] = __builtin_nontemporal_load((const f32x4*)(C0 + (size_t)(32 * w + rr + u) * 256) + lane);
#pragma unroll
        for (int u = 0; u < 8; ++u) { const int d = 32 * w + rr + u; const float qd = Lq[d], kd = Lk[d] * win; qc += c[u] * qd;
            __builtin_nontemporal_store(c[u] * winter + vv * kd, (f32x4*)(C1 + (size_t)d * 256) + lane); }
    }
    *(LAS f32x4*)(RED + w * 256 + 4 * lane) = qc;
    if (tid < 256) F.out[O_NS + (size_t)(b * 4 + h) * 256 + tid] = winter * Ln[tid] + win * Lk[tid];
    if (tid == 0) F.out[O_MS + b * 4 + h] = Lsc[5];
    __syncthreads();
    if (w == 0) {
        f32x4 s = {0.f, 0.f, 0.f, 0.f};
#pragma unroll
        for (int u = 0; u < 8; ++u) s += *(const LAS f32x4*)(RED + u * 256 + 4 * lane);
        const float inv = 1.f / fmaxf(fabsf(Lsc[3]), Lsc[4]);
        f32x4 hv = (vv * Lsc[2] + s * winter) * inv;
        const float mu = wave_sum(hv[0] + hv[1] + hv[2] + hv[3]) * (1.f / 256.f);
        hv = hv - mu;
        const float var = wave_sum(hv[0] * hv[0] + hv[1] * hv[1] + hv[2] * hv[2] + hv[3] * hv[3]) * (1.f / 256.f);
        const float rstd = 1.f / sqrtf(var + EPS);
        const f32x4 wn = *(const f32x4*)(F.w_mnorm + h * 256 + 4 * lane);
        const v2u mo = *(const GAS v2u*)(MO + drow * 1024 + h * 256 + 4 * lane); const v2u sg = *(const GAS v2u*)((const bf16*)(F.ws + WS_SG) + drow * 2048 + h * 256 + 4 * lane);
        v2u ov; ov.x = cvtpk(hv[0] * rstd * wn[0] * sigmoid_f(bflo(mo.x)) * bflo(sg.x), hv[1] * rstd * wn[1] * sigmoid_f(bfhi(mo.x)) * bfhi(sg.x));
        ov.y = cvtpk(hv[2] * rstd * wn[2] * sigmoid_f(bflo(mo.y)) * bflo(sg.y), hv[3] * rstd * wn[3] * sigmoid_f(bfhi(mo.y)) * bfhi(sg.y));
        *(GAS v2u*)((bf16*)(F.ws + WS_H) + drow * 2048 + h * 256 + 4 * lane) = ov;
    }
    __syncthreads();
}
__device__ __forceinline__ void p2_dec_memattn(Frame& F, int unit) {
    const int b = unit >> 2, h = unit & 3, tid = F.tid, lane = F.lane, w = F.wave, half = lane >> 5, l32 = lane & 31;
    LAS float* SC = (LAS float*)(F.lds); LAS float* Lsc = SC + 256; LAS float* RED = Lsc + 64;
    const size_t drow = (size_t)MP + b;
    const bf16* CQ = (const bf16*)(F.ws + WS_DQ + 3 * SZ_R512);
    const v2u qw = *(const GAS v2u*)(CQ + drow * 512 + h * 128 + 4 * l32);
    const f32x4 qv = {bflo(qw.x), bfhi(qw.x), bflo(qw.y), bfhi(qw.y)};
    const float* Kb = F.cmem_k + ((size_t)b * 256 * 4 + h) * 128 + 4 * l32; const float* Vb = F.cmem_v + ((size_t)b * 256 * 4 + h) * 128 + 4 * l32;
#pragma unroll
    for (int it = 0; it < 16; it += 8) {
        f32x4 kv[8];
#pragma unroll
        for (int u = 0; u < 8; ++u) kv[u] = __builtin_nontemporal_load((const f32x4*)(Kb + (size_t)(32 * w + 2 * (it + u) + half) * 512));
#pragma unroll
        for (int u = 0; u < 8; ++u) { float p = kv[u][0] * qv[0] + kv[u][1] * qv[1] + kv[u][2] * qv[2] + kv[u][3] * qv[3];
            p += __shfl_xor(p, 1); p += __shfl_xor(p, 2); p += __shfl_xor(p, 4); p += __shfl_xor(p, 8); p += __shfl_xor(p, 16);
            if (l32 == 0) SC[32 * w + 2 * (it + u) + half] = p; }
    }
    __syncthreads();
    if (w == 0) {
        const f32x4 sv = *(const LAS f32x4*)(SC + 4 * lane);
        const float mx = wave_max(fmaxf(fmaxf(sv[0], sv[1]), fmaxf(sv[2], sv[3])));
        const f32x4 pv = {fexp2(sv[0] - mx), fexp2(sv[1] - mx), fexp2(sv[2] - mx), fexp2(sv[3] - mx)};
        const float l = wave_sum(pv[0] + pv[1] + pv[2] + pv[3]);
        *(LAS f32x4*)(SC + 4 * lane) = pv; if (lane == 0) Lsc[0] = 1.f / l;
    }
    __syncthreads();
    f32x4 acc = {0.f, 0.f, 0.f, 0.f};
#pragma unroll
    for (int it = 0; it < 16; it += 8) {
        f32x4 vv[8];
#pragma unroll
        for (int u = 0; u < 8; ++u) vv[u] = __builtin_nontemporal_load((const f32x4*)(Vb + (size_t)(32 * w + 2 * (it + u) + half) * 512));
#pragma unroll
        for (int u = 0; u < 8; ++u) acc += vv[u] * SC[32 * w + 2 * (it + u) + half];
    }
    acc[0] += swap32(acc[0]); acc[1] += swap32(acc[1]); acc[2] += swap32(acc[2]); acc[3] += swap32(acc[3]);
    if (half == 0) *(LAS f32x4*)(RED + w * 128 + 4 * l32) = acc;
    __syncthreads();
    if (tid < 32) {
        f32x4 s = {0.f, 0.f, 0.f, 0.f};
#pragma unroll
        for (int u = 0; u < 8; ++u) s += *(const LAS f32x4*)(RED + u * 128 + 4 * tid);
        s = s * Lsc[0];
        const size_t off = drow * 2048 + 1536 + h * 128 + 4 * tid; const v2u sg = *(const GAS v2u*)((const bf16*)(F.ws + WS_SG) + off);
        v2u ov; ov.x = cvtpk(s[0] * bflo(sg.x), s[1] * bfhi(sg.x)); ov.y = cvtpk(s[2] * bflo(sg.y), s[3] * bfhi(sg.y));
        *(GAS v2u*)((bf16*)(F.ws + WS_H) + off) = ov;
    }
    __syncthreads();
}
__device__ __forceinline__ void p2_dec_diff(Frame& F, int unit) {
    const int b = unit >> 4, pg = unit & 15, tid = F.tid, lane = F.lane, w = F.wave;
    LAS float* SC = (LAS float*)(F.lds);
    LAS float* Lm = SC + 1024;
    LAS float* RED = Lm + 64;
    const size_t drow = (size_t)MP + b;
    const int phys = F.page_table[b * NPAGES + pg];
    const float* Kp = F.cache_k + (size_t)phys * PAGE * 512; const float* Vp = F.cache_v + (size_t)phys * PAGE * 512;
    const bf16* DQ = (const bf16*)(F.ws + WS_DQ);
    const v2u qa = *(const GAS v2u*)(DQ + drow * 512 + 4 * lane), qb = *(const GAS v2u*)(DQ + drow * 512 + 256 + 4 * lane);
    const f32x4 qA = {bflo(qa.x), bfhi(qa.x), bflo(qa.y), bfhi(qa.y)}, qB = {bflo(qb.x), bfhi(qb.x), bflo(qb.y), bfhi(qb.y)};
#pragma unroll
    for (int it = 0; it < 16; it += 8) {
        f32x4 ka[8], kb[8];
#pragma unroll
        for (int u = 0; u < 8; ++u) { const float* kr = Kp + (size_t)(16 * w + it + u) * 512; ka[u] = __builtin_nontemporal_load((const f32x4*)kr + lane); kb[u] = __builtin_nontemporal_load((const f32x4*)(kr + 256) + lane); }
#pragma unroll
        for (int u = 0; u < 8; ++u) { float pa = ka[u][0] * qA[0] + ka[u][1] * qA[1] + ka[u][2] * qA[2] + ka[u][3] * qA[3], pb = kb[u][0] * qB[0] + kb[u][1] * qB[1] + kb[u][2] * qB[2] + kb[u][3] * qB[3];
            pa += __shfl_xor(pa, 1); pb += __shfl_xor(pb, 1); pa += __shfl_xor(pa, 2); pb += __shfl_xor(pb, 2); pa += __shfl_xor(pa, 4); pb += __shfl_xor(pb, 4); pa += __shfl_xor(pa, 8); pb += __shfl_xor(pb, 8);
            if ((lane & 15) == 0) { SC[(16 * w + it + u) * 8 + (lane >> 4)] = pa; SC[(16 * w + it + u) * 8 + 4 + (lane >> 4)] = pb; } }
    }
    __syncthreads();
    {
        const float s0 = SC[lane * 8 + w], s1 = SC[(lane + 64) * 8 + w];
        const float mx = wave_max(fmaxf(s0, s1)); const float p0 = fexp2(s0 - mx), p1 = fexp2(s1 - mx); const float l = wave_sum(p0 + p1);
        SC[lane * 8 + w] = p0; SC[(lane + 64) * 8 + w] = p1; if (lane == 0) { Lm[w] = mx; Lm[8 + w] = l; }
    }
    __syncthreads();
    f32x4 a0A = {0.f, 0.f, 0.f, 0.f}, a1A = a0A, a0B = a0A, a1B = a0A;
    const int hA = lane >> 5;
#pragma unroll
    for (int it = 0; it < 16; it += 8) {
        f32x4 va[8], vb[8];
#pragma unroll
        for (int u = 0; u < 8; ++u) { const float* vr = Vp + (size_t)(16 * w + it + u) * 512; va[u] = __builtin_nontemporal_load((const f32x4*)vr + lane); vb[u] = __builtin_nontemporal_load((const f32x4*)(vr + 256) + lane); }
#pragma unroll
        for (int u = 0; u < 8; ++u) { const LAS float* pp = SC + (16 * w + it + u) * 8;
            a0A += va[u] * pp[2 * hA]; a1A += va[u] * pp[2 * hA + 1]; a0B += vb[u] * pp[4 + 2 * hA]; a1B += vb[u] * pp[4 + 2 * hA + 1]; }
    }
    *(LAS f32x4*)(RED + (w * 4 + 0) * 256 + 4 * lane) = a0A; *(LAS f32x4*)(RED + (w * 4 + 1) * 256 + 4 * lane) = a0B;
    *(LAS f32x4*)(RED + (w * 4 + 2) * 256 + 4 * lane) = a1A; *(LAS f32x4*)(RED + (w * 4 + 3) * 256 + 4 * lane) = a1B;
    __syncthreads();
    float* PART = (float*)(F.ws + WS_PART) + (size_t)(b * NPAGES + pg) * 8 * 136;
    if (tid < 256) { const int cs = tid >> 6, ln = tid & 63, c = cs >> 1, slot = cs & 1, hh = 2 * slot + (ln >> 5), dv = 4 * (ln & 31);
        f32x4 s = {0.f, 0.f, 0.f, 0.f};
#pragma unroll
        for (int u = 0; u < 8; ++u) s += *(const LAS f32x4*)(RED + (u * 4 + cs) * 256 + 4 * ln);
        *(GAS f32x4*)(PART + (hh * 2 + c) * 136 + 8 + dv) = s; }
    if (tid < 8) { PART[tid * 136] = Lm[tid]; PART[tid * 136 + 1] = Lm[8 + tid]; }
    __syncthreads();
}

__device__ __forceinline__ void p3_assemble(Frame& F) {
    const int gw = F.vcu * NWAVES + F.wave, NGW = F.G * NWAVES, lane = F.lane;
    const float lam = lam_value(F);
    const float* HM = (const float*)(F.ws + WS_HM); const bf16* MO = (const bf16*)(F.ws + WS_QM + 3 * SZ_R1024); const bf16* OD = (const bf16*)(F.ws + WS_OD);
    const bf16* SG = (const bf16*)(F.ws + WS_SG); bf16* H = (bf16*)(F.ws + WS_H);
    const f32x2 wd = *(const f32x2*)(F.w_dnorm + 2 * lane);
    for (int row = gw; row < MP; row += NGW) {
#pragma unroll
        for (int h = 0; h < 4; ++h) {
            const size_t off1 = (size_t)row * 1024 + h * 256 + 4 * lane, off2 = (size_t)row * 2048 + h * 256 + 4 * lane;
            f32x4 hv = *(const GAS f32x4*)(HM + off1);
            const float mu = wave_sum(hv[0] + hv[1] + hv[2] + hv[3]) * (1.f / 256.f); hv = hv - mu;
            const float var = wave_sum(hv[0] * hv[0] + hv[1] * hv[1] + hv[2] * hv[2] + hv[3] * hv[3]) * (1.f / 256.f); const float rstd = 1.f / sqrtf(var + EPS);
            const f32x4 wn = *(const f32x4*)(F.w_mnorm + h * 256 + 4 * lane); const v2u mo = *(const GAS v2u*)(MO + off1); const v2u sg = *(const GAS v2u*)(SG + off2);
            v2u ov; ov.x = cvtpk(hv[0] * rstd * wn[0] * sigmoid_f(bflo(mo.x)) * bflo(sg.x), hv[1] * rstd * wn[1] * sigmoid_f(bfhi(mo.x)) * bfhi(sg.x));
            ov.y = cvtpk(hv[2] * rstd * wn[2] * sigmoid_f(bflo(mo.y)) * bflo(sg.y), hv[3] * rstd * wn[3] * sigmoid_f(bfhi(mo.y)) * bfhi(sg.y));
            *(GAS v2u*)(H + off2) = ov; }
#pragma unroll
        for (int h = 0; h < 4; ++h) {
            const unsigned o1 = *(const GAS unsigned*)(OD + (size_t)row * 1024 + (h * 2) * 128 + 2 * lane), o2 = *(const GAS unsigned*)(OD + (size_t)row * 1024 + (h * 2 + 1) * 128 + 2 * lane);
            const float x0 = bflo(o1) - lam * bflo(o2), x1 = bfhi(o1) - lam * bfhi(o2);
            const float ms = wave_sum(x0 * x0 + x1 * x1) * (1.f / 128.f); const float r = (1.f - LAM_INIT) / sqrtf(ms + EPS);
            const size_t off = (size_t)row * 2048 + 1024 + h * 128 + 2 * lane; const unsigned sg = *(const GAS unsigned*)(SG + off);
            *(GAS unsigned*)(H + off) = cvtpk(x0 * r * wd[0] * bflo(sg), x1 * r * wd[1] * bfhi(sg)); }
    }
    const float* PART = (const float*)(F.ws + WS_PART); const bf16* DQ = (const bf16*)(F.ws + WS_DQ); const bf16* DK = (const bf16*)(F.ws + WS_DQ + SZ_R512); const bf16* DV = (const bf16*)(F.ws + WS_DQ + 2 * SZ_R512);
    for (int u = gw; u < DEC_B * 4; u += NGW) {
        const int b = u >> 2, h = u & 3; const size_t drow = (size_t)MP + b;
        float oc[2][2];
#pragma unroll
        for (int c = 0; c < 2; ++c) {
            const float qv = bf2f(DQ[drow * 512 + (h * 2 + c) * 64 + lane]), kv = bf2f(DK[drow * 512 + (h * 2 + c) * 64 + lane]);
            const float sn = wave_sum(qv * kv);
            float mp = (lane < 16) ? PART[((size_t)(b * NPAGES + lane) * 8 + h * 2 + c) * 136] : -INFINITY;
            const float lp = (lane < 16) ? PART[((size_t)(b * NPAGES + lane) * 8 + h * 2 + c) * 136 + 1] : 0.f;
            const float M = fmaxf(wave_max(mp), sn);
            const float sc = (lane < 16) ? fexp2(mp - M) : 0.f; const float wnew = fexp2(sn - M);
            const float Lt = wave_sum(lp * sc) + wnew;
            const unsigned vn = *(const GAS unsigned*)(DV + drow * 512 + h * 128 + 2 * lane);
            float a0 = wnew * bflo(vn), a1 = wnew * bfhi(vn);
#pragma unroll
            for (int pg = 0; pg < 16; ++pg) { const float s = __shfl(sc, pg); const f32x2 ov = *(const GAS f32x2*)(PART + ((size_t)(b * NPAGES + pg) * 8 + h * 2 + c) * 136 + 8 + 2 * lane); a0 += s * ov[0]; a1 += s * ov[1]; }
            const float il = 1.f / Lt; oc[c][0] = a0 * il; oc[c][1] = a1 * il;
        }
        const float x0 = oc[0][0] - lam * oc[1][0], x1 = oc[0][1] - lam * oc[1][1];
        const float ms = wave_sum(x0 * x0 + x1 * x1) * (1.f / 128.f); const float r = (1.f - LAM_INIT) / sqrtf(ms + EPS);
        const size_t off = drow * 2048 + 1024 + h * 128 + 2 * lane; const unsigned sg = *(const GAS unsigned*)(SG + off);
        *(GAS unsigned*)(H + off) = cvtpk(x0 * r * wd[0] * bflo(sg), x1 * r * wd[1] * bfhi(sg));
    }
    for (int i = (F.vcu * NWAVES * 64) + F.tid; i < (MROWS - MTOK) * 2048 / 8; i += F.G * NWAVES * 64) *((GAS v4u*)(H + (size_t)MTOK * 2048) + i) = (v4u){0u, 0u, 0u, 0u};
}

__device__ __forceinline__ void p5_layernorm(Frame& F) {
    const int gw = F.vcu * NWAVES + F.wave, NGW = F.G * NWAVES, lane = F.lane;
    const float* Y = (const float*)(F.ws + WS_Y);
    for (int row = gw; row < MTOK; row += NGW) {
        const GAS f32x4* yr = (const GAS f32x4*)(Y + (size_t)row * 1024) + lane;
        f32x4 v[4]; float s = 0.f;
#pragma unroll
        for (int j = 0; j < 4; ++j) { v[j] = yr[64 * j]; s += (v[j].x + v[j].y) + (v[j].z + v[j].w); }
        const float mean = wave_sum(s) * (1.f / 1024.f); float s2 = 0.f;
#pragma unroll
        for (int j = 0; j < 4; ++j) { v[j] = v[j] - mean; s2 += (v[j].x * v[j].x + v[j].y * v[j].y) + (v[j].z * v[j].z + v[j].w * v[j].w); }
        const float rstd = 1.f / sqrtf(wave_sum(s2) * (1.f / 1024.f) + EPS);
        float* orow = row < MP ? F.out + O_YP + (size_t)row * 1024 : F.out + O_YS + (size_t)(row - MP) * 1024;
#pragma unroll
        for (int j = 0; j < 4; ++j) { const f32x4 g = *((const f32x4*)F.ln_g + lane + 64 * j), bb = *((const f32x4*)F.ln_b + lane + 64 * j); *((GAS f32x4*)orow + lane + 64 * j) = v[j] * rstd * g + bb; }
    }
}

struct Args { const void* in[23]; float* out; unsigned char* ws; int ph_lo, ph_hi, li, pad; };
__global__ void __launch_bounds__(NWAVES * 64, 2) mk_fwd(Args args) {
    extern __shared__ __attribute__((aligned(16))) unsigned char lds[];
    Frame F;
    F.lds = (LAS unsigned char*)lds;
    F.MISC = (volatile LAS unsigned*)(F.lds + MISC_OFF);
    F.tid = threadIdx.x; F.lane = F.tid & 63; F.wave = __builtin_amdgcn_readfirstlane(F.tid >> 6);
    F.G = gridDim.x; { const int bx = blockIdx.x; F.vcu = (F.G % 8 == 0) ? (bx % 8) * (F.G / 8) + bx / 8 : bx; }
#define GRID_BAR(seam) do { if (N_LAUNCHES == PER_PHASE) { if (F.tid == 0) __hip_atomic_store(F.ctl + CW_TMO, 0xBADBA0u | (unsigned)(seam), RLX_AGENT); } \
    else { xcd_barrier(bar); } } while (0)
    unsigned char* ws = args.ws;
    F.ws = ws; F.out = args.out;
    F.ctl = (gu32*)(ws + WS_CTL);
    F.x_prompt = (const float*)args.in[0]; F.x_sample = (const float*)args.in[1]; F.st_c = (const float*)args.in[2]; F.st_n = (const float*)args.in[3]; F.st_m = (const float*)args.in[4];
    F.cache_k = (const float*)args.in[5]; F.cache_v = (const float*)args.in[6]; F.cmem_k = (const float*)args.in[7]; F.cmem_v = (const float*)args.in[8]; F.page_table = (const int*)args.in[9];
    F.mem_prompt = (const float*)args.in[10]; F.w_in = (const float*)args.in[11]; F.b_if = (const float*)args.in[12]; F.w_mnorm = (const float*)args.in[13];
    F.lq1 = (const float*)args.in[14]; F.lk1 = (const float*)args.in[15]; F.lq2 = (const float*)args.in[16]; F.lk2 = (const float*)args.in[17]; F.w_dnorm = (const float*)args.in[18];
    F.w_memkv = (const float*)args.in[19]; F.w_out = (const float*)args.in[20]; F.ln_g = (const float*)args.in[21]; F.ln_b = (const float*)args.in[22];
    for (int u = F.tid; u < (LDS_BYTES - LDSCTL_OFF) / 4; u += NWAVES * 64) ((LAS unsigned*)(F.lds + LDSCTL_OFF))[u] = 0u;
    __syncthreads();
    const int bli = (N_LAUNCHES == PER_PHASE) ? 0 : args.li;
    XcdBarrier bar; bar.bar = (unsigned*)(F.ctl + CW_BAR) + bli * XCD_BAR_WORDS; bar.x = 0; bar.st = nullptr;
    if (N_LAUNCHES != PER_PHASE) bar = xcd_barrier_post((unsigned*)(F.ctl + CW_BAR) + bli * XCD_BAR_WORDS, F.MISC + 8);
    const int lo = args.ph_lo, hi = args.ph_hi;
#define IN(k) (lo <= (k) && (k) < hi)
#define BOTH(k) (IN(k) && IN((k) + 1))

    if (IN(0)) { p0_prologue(F); if (BOTH(0)) GRID_BAR(0); }

    if (IN(1)) {
        { pg8::Gemm g{(const pg8::bf16_t*)(ws + WS_XB), (const pg8::bf16_t*)(ws + WS_WINT), MROWS, NZ, 1024}; pg8::StaticOrder S; S.init(MROWS, NZ, F.G, (int)blockIdx.x);
          pg8::EpiZ E{ws, F.out};
          pg8::gemm_phase<pg8::EpiZ, pg8::StaticOrder, PG8_ALIGN, PG8_SP2>(F.lds + RING_OFF, g, S, E); }
        __syncthreads();
        { pg8::Gemm g{(const pg8::bf16_t*)(ws + WS_MEMB), (const pg8::bf16_t*)(ws + WS_WMEMT), BATCH * N_MEM, 1024, 1024}; pg8::StaticOrder S; S.init(BATCH * N_MEM, 1024, F.G, (int)blockIdx.x);
          pg8::EpiMem E{ws, F.out};
          pg8::gemm_phase<pg8::EpiMem, pg8::StaticOrder, PG8_ALIGN, PG8_SP2>(F.lds + RING_OFF, g, S, E); }
        if (BOTH(1)) GRID_BAR(1);
    }

    if (IN(2)) {
        p2_mlstm(F);
        __syncthreads();
        p2_diffattn(F, (char*)lds + RING_OFF);
        __syncthreads();
        p2_memattn(F);
        __syncthreads();
        for (int u = F.vcu; u < DEC_B * 4; u += F.G) p2_dec_mlstm(F, u);
        for (int u = F.vcu; u < DEC_B * 4; u += F.G) p2_dec_memattn(F, u);
        for (int u = F.vcu; u < DEC_B * NPAGES; u += F.G) p2_dec_diff(F, u);
        if (BOTH(2)) GRID_BAR(2);
    }

    if (IN(3)) { p3_assemble(F); if (BOTH(3)) GRID_BAR(3); }

    if (IN(4)) {
        pg8::Gemm g{(const pg8::bf16_t*)(ws + WS_H), (const pg8::bf16_t*)(ws + WS_WOUTT), MROWS, 1024, 2048}; pg8::StaticOrder S; S.init(MROWS, 1024, F.G, (int)blockIdx.x);
        pg8::EpiOut E{F.x_prompt, F.x_sample, (float*)(ws + WS_Y)};
        pg8::gemm_phase<pg8::EpiOut, pg8::StaticOrder, PG8_ALIGN, PG8_SP2>(F.lds + RING_OFF, g, S, E);
        if (BOTH(4)) GRID_BAR(4);
    }

    if (IN(5)) { p5_layernorm(F); }
#undef IN
#undef BOTH
}

extern "C" void kernel_launch(void* const* d_in, const int* in_sizes, int n_in, void* d_out, int out_size, void* d_ws, size_t ws_size, hipStream_t stream) {
    static int grid = 0;
    if (grid == 0) {
        if (n_in != 23 || in_sizes[0] != MP * 1024 || (size_t)out_size != O_END || ws_size < WS_END) { fprintf(stderr, "kernel_launch: unexpected shapes: n_in %d in0 %d out %d ws %zu\n", n_in, n_in > 0 ? in_sizes[0] : -1, out_size, ws_size); grid = -1; return; }
        int dev = 0, cus = 0, per_cu = 0;
        if (hipGetDevice(&dev) != hipSuccess || hipDeviceGetAttribute(&cus, hipDeviceAttributeMultiprocessorCount, dev) != hipSuccess) { grid = -1; return; }
        if (hipFuncSetAttribute((const void*)mk_fwd, hipFuncAttributeMaxDynamicSharedMemorySize, LDS_BYTES) != hipSuccess) { fprintf(stderr, "kernel_launch: hipFuncSetAttribute failed\n"); grid = -1; return; }
        if (hipOccupancyMaxActiveBlocksPerMultiprocessor(&per_cu, (const void*)mk_fwd, NWAVES * 64, LDS_BYTES) != hipSuccess || per_cu < 1) { fprintf(stderr, "kernel_launch: occupancy query reports %d\n", per_cu); }
        (void)hipGetLastError();
        grid = cus;
        if (grid != 256) { fprintf(stderr, "kernel_launch: %d CUs; this kernel's static work split needs 256\n", grid); grid = -1; return; }
    }
    if (grid < 0) return;
    if (hipMemsetAsync((char*)d_ws + WS_CTL, 0, CTL_ZERO_BYTES, stream) != hipSuccess) return;
    Args a{};
    for (int i = 0; i < 23; ++i) a.in[i] = d_in[i];
    a.out = (float*)d_out; a.ws = (unsigned char*)d_ws;
    for (int li = 0; li < N_LAUNCHES; ++li) {
        a.ph_lo = (N_LAUNCHES == PER_PHASE) ? li : 0; a.ph_hi = (N_LAUNCHES == PER_PHASE) ? li + 1 : PER_PHASE; a.li = li; a.pad = 0;
        hipLaunchKernelGGL(mk_fwd, dim3(grid), dim3(NWAVES * 64), LDS_BYTES, stream, a);
        const hipError_t le = hipPeekAtLastError();
        if (le != hipSuccess) { fprintf(stderr, "kernel_launch: launch %d failed: %s\n", li, hipGetErrorName(le)); break; }
    }
}
```
